# Optimizing an MI355X kernel written in HIP

```python
import math
import jax
import jax.numpy as jnp
from jax import lax
import numpy as np

D_MODEL = 2048
BATCH = 4
SEQ = 4096
DEPTH = 2

CHUNK = 64
N_LEFT_CHUNKS = 8
BAND = (N_LEFT_CHUNKS + 1) * CHUNK
HEAD_DIM = 64
D_ATT = D_MODEL // 2
N_HEADS_ATT = D_ATT // HEAD_DIM
REL_CLIP = 128
N_REL = (CHUNK - 1) + REL_CLIP + 1
D_RWKV = D_MODEL // 2
N_HEADS_RWKV = D_RWKV // HEAD_DIM
DECAY_LORA = 64
AAA_LORA = 64
GATE_LORA = 128
N_B_IN = 3 * D_RWKV + DECAY_LORA + AAA_LORA + GATE_LORA
N_IN_AB = 3 * D_ATT + N_B_IN
D_SSM = D_MODEL // 2
SSM_GROUP = 16
N_SSM_GROUPS = D_SSM // SSM_GROUP
SSM_STATE = 64
D_FF = 5632
D_PLE = 256
RMS_EPS = 1e-6
GN_EPS = 64e-5

kernel_name = 'hybrid_chunk_causal_encoder'


def rms_norm(x, g):
    xf = x.astype(jnp.float32)
    y = xf * lax.rsqrt(jnp.mean(xf * xf, axis=-1, keepdims=True) + RMS_EPS)
    return (y * g.astype(jnp.float32)).astype(x.dtype)


def swiglu_ffn(x, w_gate, w_up, w_down):
    return (jax.nn.silu(x @ w_gate) * (x @ w_up)) @ w_down


def rel_bias_index():
    i = np.arange(CHUNK)[:, None]
    j = np.arange(BAND)[None, :]
    dist = i + N_LEFT_CHUNKS * CHUNK - j
    return np.clip(dist, -(CHUNK - 1), REL_CLIP) + (CHUNK - 1)


def chunked_band_attention(q, k, v, q_gain, k_gain, rel_bias):
    bsz, t, h, dh = q.shape
    n_chunks = t // CHUNK
    pad = N_LEFT_CHUNKS * CHUNK
    q = rms_norm(q, q_gain) * (dh ** -0.5)
    k = rms_norm(k, k_gain)
    k_pad = jnp.pad(k, ((0, 0), (pad, 0), (0, 0), (0, 0)))
    v_pad = jnp.pad(v, ((0, 0), (pad, 0), (0, 0), (0, 0)))
    bias = rel_bias.astype(jnp.float32)[:, rel_bias_index()]
    q_chunks = jnp.swapaxes(q.reshape(bsz, n_chunks, CHUNK, h, dh), 0, 1)
    band_pos = jnp.arange(BAND)

    def one_chunk(args):
        c, q_c = args
        start = c * CHUNK
        k_b = lax.dynamic_slice_in_dim(k_pad, start, BAND, axis=1)
        v_b = lax.dynamic_slice_in_dim(v_pad, start, BAND, axis=1)
        s = jnp.einsum('bqhd,bkhd->bhqk', q_c, k_b).astype(jnp.float32) + bias
        valid = (start + band_pos) >= pad
        s = jnp.where(valid, s, -jnp.inf)
        prob = jax.nn.softmax(s, axis=-1).astype(v.dtype)
        return jnp.einsum('bhqk,bkhd->bqhd', prob, v_b)

    out = lax.map(one_chunk, (jnp.arange(n_chunks), q_chunks))
    return jnp.swapaxes(out, 0, 1).reshape(bsz, t, h, dh)


def token_shift(z, mu):
    prev = jnp.pad(z[:, :-1], ((0, 0), (1, 0), (0, 0)))
    return z + (prev - z) * mu


def rwkv7_time_mix(z, mu, w0, w_up, a0, a_up, g_up, k_k, k_a, r_k, lnx_w, lnx_b):
    f32 = jnp.float32
    bsz, t, _ = z.shape
    z = token_shift(z.astype(f32), mu.astype(f32))
    o1, o2, o3 = D_RWKV, 2 * D_RWKV, 3 * D_RWKV
    o4 = o3 + DECAY_LORA
    o5 = o4 + AAA_LORA
    r, k, v = z[..., :o1], z[..., o1:o2], z[..., o2:o3]
    xw, xa, xg = z[..., o3:o4], z[..., o4:o5], z[..., o5:]
    w_log = -jax.nn.softplus(-(w0.astype(f32) + jnp.tanh(xw) @ w_up.astype(f32))) - 0.5
    decay = jnp.exp(-jnp.exp(w_log))
    a = jax.nn.sigmoid(a0.astype(f32) + xa @ a_up.astype(f32))
    g = jax.nn.sigmoid(xg) @ g_up.astype(f32)

    def heads(u):
        return u.reshape(bsz, t, N_HEADS_RWKV, HEAD_DIM)

    kk = heads(k * k_k.astype(f32))
    kk = kk / jnp.maximum(jnp.sqrt(jnp.sum(kk * kk, axis=-1, keepdims=True)), 1e-12)
    k = k * (1.0 + (a - 1.0) * k_a.astype(f32))
    r_h, k_h, v_h, w_h, a_h = heads(r), heads(k), heads(v), heads(decay), heads(a)

    def step(state, inp):
        r_t, w_t, k_t, v_t, ia_t, ib_t = inp
        sa = jnp.einsum('bhvk,bhk->bhv', state, ia_t)
        state = (state * w_t[:, :, None, :] + sa[..., None] * ib_t[:, :, None, :]
                 + v_t[..., None] * k_t[:, :, None, :])
        return state, jnp.einsum('bhvk,bhk->bhv', state, r_t)

    def tm(u):
        return jnp.swapaxes(u, 0, 1)

    s0 = jnp.zeros((bsz, N_HEADS_RWKV, HEAD_DIM, HEAD_DIM), f32)
    _, y = lax.scan(step, s0, (tm(r_h), tm(w_h), tm(k_h), tm(v_h), tm(-kk), tm(kk * a_h)))
    y = tm(y)
    mean = jnp.mean(y, axis=-1, keepdims=True)
    var = jnp.mean(jnp.square(y - mean), axis=-1, keepdims=True)
    y = ((y - mean) * lax.rsqrt(var + GN_EPS)).reshape(bsz, t, D_RWKV)
    y = y * lnx_w.astype(f32) + lnx_b.astype(f32)
    bonus = jnp.sum(r_h * k_h * r_k.astype(f32), axis=-1, keepdims=True) * v_h
    return (y + bonus.reshape(bsz, t, D_RWKV)) * g


def attn_rwkv_mixer(h, w_in, q_gain, k_gain, rel_bias, mu, w0, w_up, a0, a_up, g_up,
                    k_k, k_a, r_k, lnx_w, lnx_b, w_out):
    bsz, t, _ = h.shape
    proj = h @ w_in

    def heads(u):
        return u.reshape(bsz, t, N_HEADS_ATT, HEAD_DIM)

    q = heads(proj[..., :D_ATT])
    k = heads(proj[..., D_ATT:2 * D_ATT])
    v = heads(proj[..., 2 * D_ATT:3 * D_ATT])
    att = chunked_band_attention(q, k, v, q_gain, k_gain, rel_bias).reshape(bsz, t, D_ATT)
    rw = rwkv7_time_mix(proj[..., 3 * D_ATT:], mu, w0, w_up, a0, a_up, g_up,
                        k_k, k_a, r_k, lnx_w, lnx_b).astype(att.dtype)
    return jnp.concatenate([att, rw], axis=-1) @ w_out


def s5_ssm(u, lam_re, lam_im, log_dt, b_re, b_im, c_re, c_im, d_skip):
    f32 = jnp.float32
    bsz, t, _ = u.shape
    G, P, GS = N_SSM_GROUPS, SSM_STATE, SSM_GROUP
    uf = u.astype(f32).reshape(bsz, t, G, GS)
    lr, li = lam_re.astype(f32), lam_im.astype(f32)
    dt = jnp.exp(log_dt.astype(f32))[:, None]
    mag = jnp.exp(lr * dt)
    ab_re, ab_im = mag * jnp.cos(li * dt), mag * jnp.sin(li * dt)
    denom = lr * lr + li * li
    z_re = ((ab_re - 1.0) * lr + ab_im * li) / denom
    z_im = (ab_im * lr - (ab_re - 1.0) * li) / denom
    br, bi = b_re.astype(f32), b_im.astype(f32)
    bb_re = z_re[..., None] * br - z_im[..., None] * bi
    bb_im = z_re[..., None] * bi + z_im[..., None] * br
    bu_re = jnp.einsum('gpc,btgc->btgp', bb_re, uf)
    bu_im = jnp.einsum('gpc,btgc->btgp', bb_im, uf)
    a_re = jnp.broadcast_to(ab_re[None, None], (1, t, G, P))
    a_im = jnp.broadcast_to(ab_im[None, None], (1, t, G, P))

    def combine(left, right):
        al_re, al_im, bl_re, bl_im = left
        ar_re, ar_im, br_re, br_im = right
        return (ar_re * al_re - ar_im * al_im,
                ar_re * al_im + ar_im * al_re,
                ar_re * bl_re - ar_im * bl_im + br_re,
                ar_re * bl_im + ar_im * bl_re + br_im)

    _, _, h_re, h_im = lax.associative_scan(combine, (a_re, a_im, bu_re, bu_im), axis=1)
    y = (jnp.einsum('gcp,btgp->btgc', c_re.astype(f32), h_re)
         - jnp.einsum('gcp,btgp->btgc', c_im.astype(f32), h_im))
    y = y + d_skip.astype(f32).reshape(G, GS) * uf
    return y.reshape(bsz, t, D_SSM).astype(u.dtype)


def s5_mixer(h, w_in, lam_re, lam_im, log_dt, b_re, b_im, c_re, c_im, d_skip, w_out):
    y = jax.nn.gelu(s5_ssm(h @ w_in, lam_re, lam_im, log_dt, b_re, b_im, c_re, c_im, d_skip))
    z = y @ w_out
    return z[..., :D_MODEL] * jax.nn.sigmoid(z[..., D_MODEL:])


def setup_inputs(seed: int = 0) -> dict:
    key = jax.random.key(seed)
    ks = iter(jax.random.split(key, 48))
    f32 = jnp.float32
    ne, no = (DEPTH + 1) // 2, DEPTH // 2
    G, P, GS = N_SSM_GROUPS, SSM_STATE, SSM_GROUP

    def normal(shape, scale):
        return jax.random.normal(next(ks), shape, f32) * scale

    def gain(shape):
        return 1.0 + normal(shape, 0.02)

    x = normal((BATCH, SEQ, D_MODEL), 1.0)
    p = normal((DEPTH, BATCH, SEQ, D_PLE), 1.0)
    ffn1_norm = gain((DEPTH, D_MODEL))
    ffn1_w_gate = normal((DEPTH, D_MODEL, D_FF), D_MODEL ** -0.5)
    ffn1_w_up = normal((DEPTH, D_MODEL, D_FF), D_MODEL ** -0.5)
    ffn1_w_down = normal((DEPTH, D_FF, D_MODEL), D_FF ** -0.5)
    mix_norm = gain((DEPTH, D_MODEL))
    ffn2_norm = gain((DEPTH, D_MODEL))
    ffn2_w_gate = normal((DEPTH, D_MODEL, D_FF), D_MODEL ** -0.5)
    ffn2_w_up = normal((DEPTH, D_MODEL, D_FF), D_MODEL ** -0.5)
    ffn2_w_down = normal((DEPTH, D_FF, D_MODEL), D_FF ** -0.5)
    ple_norm = gain((DEPTH, D_MODEL))
    ple_w_gate = normal((DEPTH, D_MODEL, D_MODEL), D_MODEL ** -0.5)
    ple_w_proj = normal((DEPTH, D_PLE, D_MODEL), D_PLE ** -0.5)
    ab_w_in = normal((ne, D_MODEL, N_IN_AB), D_MODEL ** -0.5)
    att_q_gain = gain((ne, HEAD_DIM))
    att_k_gain = gain((ne, HEAD_DIM))
    att_rel_bias = normal((ne, N_HEADS_ATT, N_REL), 0.1)
    rwkv_mu = jax.random.uniform(next(ks), (ne, N_B_IN), f32)
    rwkv_w0 = jnp.linspace(-6.0, -1.0, D_RWKV, dtype=f32) + normal((ne, D_RWKV), 0.1)
    rwkv_w_up = normal((ne, DECAY_LORA, D_RWKV), 0.1 * DECAY_LORA ** -0.5)
    rwkv_a0 = normal((ne, D_RWKV), 0.1)
    rwkv_a_up = normal((ne, AAA_LORA, D_RWKV), 0.5 * AAA_LORA ** -0.5)
    rwkv_g_up = normal((ne, GATE_LORA, D_RWKV), GATE_LORA ** -0.5)
    rwkv_k_k = 0.85 + normal((ne, D_RWKV), 0.02)
    rwkv_k_a = gain((ne, D_RWKV))
    rwkv_r_k = normal((ne, N_HEADS_RWKV, HEAD_DIM), 0.1)
    rwkv_lnx_w = gain((ne, D_RWKV))
    rwkv_lnx_b = normal((ne, D_RWKV), 0.02)
    ab_w_out = normal((ne, D_ATT + D_RWKV, D_MODEL), (D_ATT + D_RWKV) ** -0.5)
    ssm_w_in = normal((no, D_MODEL, D_SSM), D_MODEL ** -0.5)
    ssm_lambda_re = -0.5 + normal((no, G, P), 0.01)
    ssm_lambda_im = math.pi * jnp.arange(P, dtype=f32) + normal((no, G, P), 0.01)
    ssm_log_dt = jax.random.uniform(next(ks), (no, G), f32, math.log(1e-3), math.log(1e-1))
    ssm_b_re = normal((no, G, P, GS), (2 * GS) ** -0.5)
    ssm_b_im = normal((no, G, P, GS), (2 * GS) ** -0.5)
    ssm_c_re = normal((no, G, GS, P), (2 * P) ** -0.5)
    ssm_c_im = normal((no, G, GS, P), (2 * P) ** -0.5)
    ssm_d = normal((no, D_SSM), 1.0)
    ssm_w_out = normal((no, D_SSM, 2 * D_MODEL), D_SSM ** -0.5)
    return {
        'x': x, 'p': p,
        'ffn1_norm': ffn1_norm, 'ffn1_w_gate': ffn1_w_gate, 'ffn1_w_up': ffn1_w_up,
        'ffn1_w_down': ffn1_w_down, 'mix_norm': mix_norm,
        'ffn2_norm': ffn2_norm, 'ffn2_w_gate': ffn2_w_gate, 'ffn2_w_up': ffn2_w_up,
        'ffn2_w_down': ffn2_w_down,
        'ple_norm': ple_norm, 'ple_w_gate': ple_w_gate, 'ple_w_proj': ple_w_proj,
        'ab_w_in': ab_w_in, 'att_q_gain': att_q_gain, 'att_k_gain': att_k_gain,
        'att_rel_bias': att_rel_bias, 'rwkv_mu': rwkv_mu, 'rwkv_w0': rwkv_w0,
        'rwkv_w_up': rwkv_w_up, 'rwkv_a0': rwkv_a0, 'rwkv_a_up': rwkv_a_up,
        'rwkv_g_up': rwkv_g_up, 'rwkv_k_k': rwkv_k_k, 'rwkv_k_a': rwkv_k_a,
        'rwkv_r_k': rwkv_r_k, 'rwkv_lnx_w': rwkv_lnx_w, 'rwkv_lnx_b': rwkv_lnx_b,
        'ab_w_out': ab_w_out,
        'ssm_w_in': ssm_w_in, 'ssm_lambda_re': ssm_lambda_re, 'ssm_lambda_im': ssm_lambda_im,
        'ssm_log_dt': ssm_log_dt, 'ssm_b_re': ssm_b_re, 'ssm_b_im': ssm_b_im,
        'ssm_c_re': ssm_c_re, 'ssm_c_im': ssm_c_im, 'ssm_d': ssm_d, 'ssm_w_out': ssm_w_out,
    }


def reference(x, p, ffn1_norm, ffn1_w_gate, ffn1_w_up, ffn1_w_down, mix_norm,
              ffn2_norm, ffn2_w_gate, ffn2_w_up, ffn2_w_down,
              ple_norm, ple_w_gate, ple_w_proj,
              ab_w_in, att_q_gain, att_k_gain, att_rel_bias, rwkv_mu, rwkv_w0,
              rwkv_w_up, rwkv_a0, rwkv_a_up, rwkv_g_up, rwkv_k_k, rwkv_k_a,
              rwkv_r_k, rwkv_lnx_w, rwkv_lnx_b, ab_w_out,
              ssm_w_in, ssm_lambda_re, ssm_lambda_im, ssm_log_dt, ssm_b_re, ssm_b_im,
              ssm_c_re, ssm_c_im, ssm_d, ssm_w_out):
    h = x
    for i in range(DEPTH):
        j = i // 2
        h = h + 0.5 * swiglu_ffn(rms_norm(h, ffn1_norm[i]), ffn1_w_gate[i],
                                 ffn1_w_up[i], ffn1_w_down[i])
        hn = rms_norm(h, mix_norm[i])
        if i % 2 == 0:
            mix = attn_rwkv_mixer(hn, ab_w_in[j], att_q_gain[j], att_k_gain[j],
                                  att_rel_bias[j], rwkv_mu[j], rwkv_w0[j], rwkv_w_up[j],
                                  rwkv_a0[j], rwkv_a_up[j], rwkv_g_up[j], rwkv_k_k[j],
                                  rwkv_k_a[j], rwkv_r_k[j], rwkv_lnx_w[j], rwkv_lnx_b[j],
                                  ab_w_out[j])
        else:
            mix = s5_mixer(hn, ssm_w_in[j], ssm_lambda_re[j], ssm_lambda_im[j],
                           ssm_log_dt[j], ssm_b_re[j], ssm_b_im[j], ssm_c_re[j],
                           ssm_c_im[j], ssm_d[j], ssm_w_out[j])
        h = h + mix
        h = h + 0.5 * swiglu_ffn(rms_norm(h, ffn2_norm[i]), ffn2_w_gate[i],
                                 ffn2_w_up[i], ffn2_w_down[i])
        gate = jax.nn.sigmoid(rms_norm(h, ple_norm[i]) @ ple_w_gate[i])
        h = h + gate * (p[i] @ ple_w_proj[i])
    return h
```

```cpp
#include <hip/hip_runtime.h>
#include <hip/hip_cooperative_groups.h>
#include <cstdio>
#include <cstdint>
namespace cg = cooperative_groups;
namespace pg8 {
#define PG8_LAS __attribute__((address_space(3)))
typedef unsigned short bf16_t;
typedef short bf16x8 __attribute__((ext_vector_type(8)));
typedef float f32x4 __attribute__((ext_vector_type(4)));
typedef unsigned u32x4 __attribute__((ext_vector_type(4)));
constexpr int BM = 256, BK = 64, HALF = 128, HTB = HALF * BK * 2  , STAGE_BYTES = 8 * HTB, NXCD = 8, WGM = 8;

__host__ __device__ __forceinline__ int lds_byte(int r, int c) { const int st = (r >> 4) * 2 + (c >> 5), rr = r & 15, cc = c & 31, ob = rr * 64 + cc * 2; return st * 1024 + (ob ^ (((ob >> 9) & 1) << 5)); }
__host__ __device__ __forceinline__ void stage_rc(int b, int& R, int& C) { const int st = b / 1024, sb = b % 1024, swz = sb ^ (((sb >> 9) & 1) << 5); R = (st >> 1) * 16 + swz / 64; C = (st & 1) * 32 + (swz % 64) / 2; }
__host__ __device__ __forceinline__ int perm32(int rho) { const int n = rho >> 4, i = rho & 15; return 8 * (i >> 2) + 4 * n + (i & 3); }

struct Unit { int pm, pn; };
struct Gemm { const bf16_t* A; const bf16_t* Bt; int M, N, K; };

struct StaticOrder {
    int nM, nN, nwg, G, c;
    __host__ __device__ void init(int M, int N, int G_, int c_) { nM = M / BM; nN = N / BM; nwg = nM * nN; G = G_; c = c_; }
    __host__ __device__ bool next(int i, Unit& u) const {
        const long L = (long)i * G + c; if (L >= nwg) return false;
        int wgid = (int)L; { const int q = nwg / NXCD, r = nwg % NXCD, xcd = wgid % NXCD, off = wgid / NXCD; wgid = (xcd < r ? xcd * (q + 1) : r * (q + 1) + (xcd - r) * q) + off; }
        const int nig = WGM * nN, gid = wgid / nig, fm = gid * WGM, gsz = (nM - fm) < WGM ? (nM - fm) : WGM;
        u.pm = fm + ((wgid % nig) % gsz); u.pn = (wgid % nig) / gsz; return true;
    }
    __device__ __forceinline__ void a_ready(const Unit&) const {}
    __device__ __forceinline__ void done(const Unit&) const {}
};

__device__ __forceinline__ unsigned cvt_pk_bf16(float lo, float hi) { unsigned r; asm volatile("v_cvt_pk_bf16_f32 %0, %1, %2" : "=v"(r) : "v"(lo), "v"(hi)); return r; }
template <class Epi, class Sched, bool ALIGN_EPI = false, bool SP2 = false>
__device__ __forceinline__ void gemm_phase(PG8_LAS unsigned char* lds, const Gemm g, const Sched& S, const Epi& E) {
    int tid_o = threadIdx.x; asm volatile("" : "+v"(tid_o));
    const int tid = tid_o, wid = __builtin_amdgcn_readfirstlane(tid >> 6), lane = tid & 63, wr = wid >> 2, wc = wid & 3, fr = lane & 15, fq = lane >> 4;
    const int K = g.K, nt = K / BK;
    unsigned voffA[2], voffB[2];
#pragma unroll
    for (int i = 0; i < 2; ++i) { int R, C; stage_rc(tid * 16 + i * 8192, R, C); const int Rb = Epi::PERM ? ((R & ~31) + perm32(R & 31)) : R;
        voffA[i] = (unsigned)(R * K + C) * 2u; voffB[i] = (unsigned)(Rb * K + C) * 2u; }
    const size_t kstep = (size_t)(BK * 2);
    const size_t hstep = (size_t)HALF * K * 2;
    const size_t tstep = 2 * hstep;
    const unsigned ldsw = (unsigned)wid * 1024u;
    const int aoff = lds_byte(wr * 64 + fr, fq * 8), boff = lds_byte(wc * 32 + fr, fq * 8);
#define PG8_SA(b, h) (((b) * 2 + (h)) * HTB)
#define PG8_SB(b, h) ((4 + (b) * 2 + (h)) * HTB)
#define PG8_STAGE(bufoff, gbase, voff) do { _Pragma("unroll") for (int _i = 0; _i < 2; ++_i) \
        __builtin_amdgcn_global_load_lds((const unsigned*)((const char*)(gbase) + (voff)[_i]), (PG8_LAS unsigned*)(lds + (bufoff) + ldsw + _i * 8192), 16, 0, 0); } while (0)
#define PG8_LDA(dst, b, h) do { _Pragma("unroll") for (int m = 0; m < 4; ++m) _Pragma("unroll") for (int k = 0; k < 2; ++k) dst[m][k] = *(const PG8_LAS bf16x8*)(lds + PG8_SA(b, h) + aoff + m * 2048 + k * 1024); } while (0)
#define PG8_LDB(dst, b, h) do { _Pragma("unroll") for (int n = 0; n < 2; ++n) _Pragma("unroll") for (int k = 0; k < 2; ++k) dst[n][k] = *(const PG8_LAS bf16x8*)(lds + PG8_SB(b, h) + boff + n * 2048 + k * 1024); } while (0)
#define PG8_MMA(ai, bj, At, Bt) do { __builtin_amdgcn_s_setprio(1); _Pragma("unroll") for (int m = 0; m < 4; ++m) _Pragma("unroll") for (int n = 0; n < 2; ++n) _Pragma("unroll") for (int k = 0; k < 2; ++k) \
        acc[ai][bj][m][n] = __builtin_amdgcn_mfma_f32_16x16x32_bf16(Bt[n][k], At[m][k], acc[ai][bj][m][n], 0, 0, 0); __builtin_amdgcn_s_setprio(0); } while (0)
#define PG8_WAIT_V(n) asm volatile("s_waitcnt vmcnt(" #n ")" ::: "memory")
#define PG8_WAIT_L(n) asm volatile("s_waitcnt lgkmcnt(" #n ")" ::: "memory")
#define PG8_BAR __builtin_amdgcn_s_barrier()
#define PG8_SCHED __builtin_amdgcn_sched_barrier(0)
    Unit cur, nxt; int ui = 0;
    if (!S.next(0, cur)) return;
    f32x4 acc[2][2][4][2];
#pragma unroll
    for (int a = 0; a < 2; ++a)
#pragma unroll
        for (int b = 0; b < 2; ++b)
#pragma unroll
            for (int m = 0; m < 4; ++m)
#pragma unroll
                for (int n = 0; n < 2; ++n) acc[a][b][m][n] = (f32x4){0.f, 0.f, 0.f, 0.f};
    bf16x8 At[4][2], B0[2][2], B1[2][2];
    const char* cA = (const char*)g.A + (size_t)cur.pm * tstep; const char* cB = (const char*)g.Bt + (size_t)cur.pn * tstep;
    S.a_ready(cur);
    if constexpr (SP2) {
        PG8_STAGE(PG8_SB(0, 0), cB, voffB); PG8_STAGE(PG8_SB(0, 1), cB + hstep, voffB); PG8_STAGE(PG8_SA(0, 0), cA, voffA); PG8_STAGE(PG8_SA(0, 1), cA + hstep, voffA);
        if (wr == 1) PG8_BAR;
        PG8_WAIT_V(2); PG8_BAR;
        PG8_STAGE(PG8_SB(1, 0), cB + kstep, voffB); PG8_STAGE(PG8_SA(1, 0), cA + kstep, voffA); PG8_STAGE(PG8_SB(1, 1), cB + hstep + kstep, voffB);
        PG8_WAIT_V(6); PG8_BAR;
    } else {
        PG8_STAGE(PG8_SB(0, 0), cB, voffB); PG8_STAGE(PG8_SA(0, 0), cA, voffA); PG8_STAGE(PG8_SB(0, 1), cB + hstep, voffB); PG8_STAGE(PG8_SA(0, 1), cA + hstep, voffA);
        if (wr == 1) PG8_BAR;
        PG8_WAIT_V(4); PG8_BAR;
        PG8_STAGE(PG8_SB(1, 0), cB + kstep, voffB); PG8_STAGE(PG8_SA(1, 0), cA + kstep, voffA); PG8_STAGE(PG8_SB(1, 1), cB + hstep + kstep, voffB);
        PG8_WAIT_V(6); PG8_BAR;
    }
    for (;;) {
        const bool has_next = S.next(ui + 1, nxt);
        const char* nA = has_next ? (const char*)g.A + (size_t)nxt.pm * tstep : cA; const char* nB = has_next ? (const char*)g.Bt + (size_t)nxt.pn * tstep : cB;
        for (int t = 0; t < nt; t += 2) {
            const bool last = (t == nt - 2);
            const char* a1 = cA + (size_t)(t + 1) * kstep;
            const char* a2 = last ? nA : cA + (size_t)(t + 2) * kstep; const char* b2 = last ? nB : cB + (size_t)(t + 2) * kstep;
            const char* a3 = a2 + kstep; const char* b3 = b2 + kstep;
            if (last && has_next) S.a_ready(nxt);
            if constexpr (SP2) {
            PG8_LDB(B0, 0, 0); PG8_LDB(B1, 0, 1); PG8_SCHED; PG8_LDA(At, 0, 0); PG8_STAGE(PG8_SA(1, 1), a1 + hstep, voffA);
            PG8_WAIT_V(8); PG8_WAIT_L(0); PG8_BAR; PG8_MMA(0, 0, At, B0); PG8_MMA(0, 1, At, B1); PG8_BAR; PG8_SCHED;
            PG8_LDA(At, 0, 1); PG8_STAGE(PG8_SB(0, 0), b2, voffB); PG8_STAGE(PG8_SB(0, 1), b2 + hstep, voffB); PG8_STAGE(PG8_SA(0, 0), a2, voffA);
            PG8_WAIT_V(8); PG8_WAIT_L(0); PG8_BAR; PG8_MMA(1, 0, At, B0); PG8_MMA(1, 1, At, B1); PG8_BAR; PG8_SCHED;
            PG8_LDB(B0, 1, 0); PG8_LDB(B1, 1, 1); PG8_SCHED; PG8_LDA(At, 1, 0); PG8_STAGE(PG8_SA(0, 1), a2 + hstep, voffA);
            PG8_WAIT_V(8); PG8_WAIT_L(0); PG8_BAR; PG8_MMA(0, 0, At, B0); PG8_MMA(0, 1, At, B1); PG8_BAR; PG8_SCHED;
            PG8_LDA(At, 1, 1); PG8_STAGE(PG8_SB(1, 0), b3, voffB); PG8_STAGE(PG8_SB(1, 1), b3 + hstep, voffB); PG8_STAGE(PG8_SA(1, 0), a3, voffA);
            PG8_WAIT_V(8); PG8_WAIT_L(0); PG8_BAR; PG8_MMA(1, 0, At, B0); PG8_MMA(1, 1, At, B1); PG8_BAR; PG8_SCHED;
            } else {
            PG8_LDB(B0, 0, 0); PG8_SCHED; PG8_LDA(At, 0, 0); PG8_STAGE(PG8_SA(1, 1), a1 + hstep, voffA);
            PG8_WAIT_L(8); PG8_BAR; PG8_WAIT_L(0); PG8_MMA(0, 0, At, B0); PG8_BAR; PG8_SCHED;
            PG8_LDB(B1, 0, 1); PG8_STAGE(PG8_SB(0, 0), b2, voffB);
            PG8_BAR; PG8_WAIT_L(0); PG8_MMA(0, 1, At, B1); PG8_BAR;
            PG8_LDA(At, 0, 1); PG8_STAGE(PG8_SA(0, 0), a2, voffA);
            PG8_BAR; PG8_WAIT_L(0); PG8_MMA(1, 0, At, B0); PG8_BAR; PG8_SCHED;
            PG8_STAGE(PG8_SB(0, 1), b2 + hstep, voffB);
            PG8_WAIT_V(6); PG8_BAR; PG8_MMA(1, 1, At, B1); PG8_BAR;
            PG8_LDB(B0, 1, 0); PG8_SCHED; PG8_LDA(At, 1, 0); PG8_STAGE(PG8_SA(0, 1), a2 + hstep, voffA);
            PG8_WAIT_L(8); PG8_BAR; PG8_WAIT_L(0); PG8_MMA(0, 0, At, B0); PG8_BAR; PG8_SCHED;
            PG8_LDB(B1, 1, 1); PG8_STAGE(PG8_SB(1, 0), b3, voffB);
            PG8_BAR; PG8_WAIT_L(0); PG8_MMA(0, 1, At, B1); PG8_BAR;
            PG8_LDA(At, 1, 1); PG8_STAGE(PG8_SA(1, 0), a3, voffA);
            PG8_BAR; PG8_WAIT_L(0); PG8_MMA(1, 0, At, B0); PG8_BAR; PG8_SCHED;
            PG8_STAGE(PG8_SB(1, 1), b3 + hstep, voffB);
            PG8_WAIT_V(6); PG8_BAR; PG8_MMA(1, 1, At, B1); PG8_BAR;
            }
        }
        if constexpr (ALIGN_EPI) { if (wr == 0) PG8_BAR; }
        if constexpr (!Epi::AFTER_DRAIN) { E(acc, cur, wr, wc, fr, fq); S.done(cur); }
        if (!has_next) break;
#pragma unroll
        for (int a = 0; a < 2; ++a)
#pragma unroll
            for (int b = 0; b < 2; ++b)
#pragma unroll
                for (int m = 0; m < 4; ++m)
#pragma unroll
                    for (int n = 0; n < 2; ++n) acc[a][b][m][n] = (f32x4){0.f, 0.f, 0.f, 0.f};
        cur = nxt; cA = nA; cB = nB; ++ui;
        if constexpr (ALIGN_EPI) { if (wr == 1) PG8_BAR; }
    }
    PG8_WAIT_V(0);
    if constexpr (!ALIGN_EPI) { if (wr == 0) PG8_BAR; }
    PG8_BAR;
    if constexpr (Epi::AFTER_DRAIN) { E.fused(acc, cur, wr, wc, fr, fq, lds, wid, lane); S.done(cur); }
#undef PG8_SA
#undef PG8_SB
#undef PG8_STAGE
#undef PG8_LDA
#undef PG8_LDB
#undef PG8_MMA
#undef PG8_WAIT_V
#undef PG8_WAIT_L
#undef PG8_BAR
#undef PG8_SCHED
}
}

#define LAS __attribute__((address_space(3)))
#define CAS __attribute__((address_space(4)))
typedef unsigned short bf16;
typedef float f32x4 __attribute__((ext_vector_type(4)));
typedef float f32x2 __attribute__((ext_vector_type(2)));
typedef float f32x16 __attribute__((ext_vector_type(16)));
typedef short bf16x8 __attribute__((ext_vector_type(8)));
typedef short s16x4 __attribute__((ext_vector_type(4)));
typedef unsigned u32x4 __attribute__((ext_vector_type(4)));
typedef unsigned u32x2 __attribute__((ext_vector_type(2)));
typedef __bf16 bf16x2_t __attribute__((ext_vector_type(2)));

constexpr int M = 16384, D = 2048, T = 4096, NB = 4, DFF = 5632, DPLE = 256;
constexpr int NIN0 = 6400, NZ = 3328, DH = 1024;
constexpr int NTHREADS = 512, NWAVES = 8;
constexpr float RMS_EPS = 1e-6f;
constexpr int SEGT = 256, NSEG = T / SEGT;
constexpr int REC = 512;

constexpr size_t SZ_WGU = (size_t)2 * DFF * D * 2, SZ_WD = (size_t)D * DFF * 2, SZ_WPG = (size_t)D * D * 2, SZ_WPP = (size_t)D * DPLE * 2;
constexpr size_t OFF_WGU1 = 0;
constexpr size_t OFF_WD1 = OFF_WGU1 + 2 * SZ_WGU;
constexpr size_t OFF_WGU2 = OFF_WD1 + 2 * SZ_WD;
constexpr size_t OFF_WD2 = OFF_WGU2 + 2 * SZ_WGU;
constexpr size_t OFF_WPG = OFF_WD2 + 2 * SZ_WD;
constexpr size_t OFF_WPP = OFF_WPG + 2 * SZ_WPG;
constexpr size_t OFF_WIN0 = OFF_WPP + 2 * SZ_WPP;
constexpr size_t OFF_WOUT0 = OFF_WIN0 + (size_t)NIN0 * D * 2;
constexpr size_t OFF_WSIN = OFF_WOUT0 + (size_t)D * D * 2;
constexpr size_t OFF_WSOUT = OFF_WSIN + (size_t)DH * D * 2;
constexpr size_t OFF_HB = OFF_WSOUT + (size_t)2 * D * DH * 2;
constexpr size_t OFF_PB = OFF_HB + (size_t)M * D * 2;
constexpr size_t OFF_SS = OFF_PB + (size_t)2 * M * DPLE * 2;
constexpr size_t OFF_R = OFF_SS + (size_t)8 * M * 4;
constexpr size_t OFF_QB = OFF_R, OFF_KB = OFF_QB + (size_t)M * DH * 2, OFF_VT = OFF_KB + (size_t)M * DH * 2, OFF_Z = OFF_VT + (size_t)M * DH * 2;
constexpr size_t OFF_U = OFF_R, OFF_YS = OFF_U + (size_t)M * DH * 2;
constexpr size_t SZ_R = (size_t)3 * M * DH * 2 + (size_t)M * NZ * 2;
static_assert(SZ_R >= (size_t)M * DFF * 2, "ACT fits the aliased region");
constexpr size_t OFF_MIX = OFF_R + SZ_R;
constexpr size_t OFF_SCAN = OFF_MIX + (size_t)M * D * 2;
constexpr size_t SZ_SCANSEG = (size_t)NB * 16 * SEGT * REC * 4;
constexpr size_t WS_END = OFF_SCAN + 2 * SZ_SCANSEG;
static_assert(WS_END <= (size_t)840 * 1000 * 1000, "workspace budget"); static_assert(2 * SZ_SCANSEG >= (size_t)M * D * 2, "HB2 fits the scan buffers");

constexpr int LDS_BYTES = 147456;

struct Params { const float* in[40]; float* out; unsigned char* ws; };
__device__ __forceinline__ const float* inp(int i) { int k = i; asm volatile("" : "+s"(k)); return ((const float* const CAS*)__builtin_amdgcn_kernarg_segment_ptr())[k]; }

__device__ __forceinline__ unsigned cvtpk(float lo, float hi) { f32x2 v = {lo, hi}; bf16x2_t b = __builtin_convertvector(v, bf16x2_t); return __builtin_bit_cast(unsigned, b); }
__device__ __forceinline__ float bf2f(unsigned short b) { return __builtin_bit_cast(float, (unsigned)b << 16); }
__device__ __forceinline__ float bflo(unsigned u) { return __builtin_bit_cast(float, u << 16); }
__device__ __forceinline__ float bfhi(unsigned u) { return __builtin_bit_cast(float, u & 0xffff0000u); }
__device__ __forceinline__ float wave_sum(float v) {
#pragma unroll
    for (int o = 1; o < 64; o <<= 1) v += __shfl_xor(v, o);
    return v;
}
__device__ __forceinline__ float fast_sigmoid(float x) { return __builtin_amdgcn_rcpf(1.0f + __expf(-x)); }

struct ConvJob { const float* W; const float* gain; bf16* WT; int K, nblk, ldw, mode, off; };
__device__ __forceinline__ void conv_item(const float* W, const float* gain, bf16* WT, int K, int nblk, int ldw, int mode, int off, LAS float* scr, int item, int lane) {
    const int kb = item / nblk, nb = item % nblk, k0 = 64 * kb, n0 = 32 * nb;
#pragma unroll 8
    for (int i = 0; i < 32; ++i) { const int kk = 2 * i + (lane >> 5); float v = W[(size_t)(k0 + kk) * ldw + n0 + (lane & 31)]; if (gain) v *= gain[k0 + kk]; scr[kk * 33 + (lane & 31)] = v; }
    asm volatile("s_waitcnt lgkmcnt(0)" ::: "memory");
    const int c = lane & 7;
    const int drow0 = mode ? ((n0 >> 7) * 256 + (n0 & 127) + off) : (n0 + off);
#pragma unroll
    for (int j = 0; j < 4; ++j) { const int n = (lane >> 3) + 8 * j; const LAS float* s = scr + (8 * c) * 33 + n;
        u32x4 o; o.x = cvtpk(s[0 * 33], s[1 * 33]); o.y = cvtpk(s[2 * 33], s[3 * 33]); o.z = cvtpk(s[4 * 33], s[5 * 33]); o.w = cvtpk(s[6 * 33], s[7 * 33]);
        *(u32x4*)(WT + (size_t)(drow0 + n) * K + k0 + 8 * c) = o; }
    asm volatile("s_waitcnt lgkmcnt(0)" ::: "memory");
}
constexpr int I_GU = (D / 64) * (DFF / 32), I_DN = (DFF / 64) * (D / 32), I_PG = (D / 64) * (D / 32), I_PP = (DPLE / 64) * (D / 32);
constexpr int I_LAYER = 4 * I_GU + 2 * I_DN + I_PG + I_PP;
constexpr int I_IN0 = (D / 64) * (NIN0 / 32), I_OUT0 = I_PG, I_SIN = (D / 64) * (DH / 32), I_SOUT = (DH / 64) * (D / 32);
constexpr int I_TOTAL = 2 * I_LAYER + I_IN0 + I_OUT0 + I_SIN + 2 * I_SOUT;

__device__ __forceinline__ void p0_prologue(unsigned char* ws, LAS unsigned char* lds, int gw, int NGW, int wave, int lane) {
    LAS float* scr = (LAS float*)(lds + wave * 16384);
    for (int it0 = gw; it0 < I_TOTAL; it0 += NGW) {
        int it = it0;
        const float* W; const float* gain = nullptr; bf16* WT; int K, N, ldw, mode = 0, off = 0;
        if (it < 2 * I_LAYER) {
            const int l = it >= I_LAYER; it -= l * I_LAYER;
            const size_t wo = (size_t)l * D * DFF;
            if (it < 2 * I_GU) { const int up = it >= I_GU; it -= up * I_GU; W = (up ? inp(4) : inp(3)) + wo; gain = inp(2) + l * D; WT = (bf16*)(ws + OFF_WGU1 + l * SZ_WGU); K = D; N = DFF; ldw = DFF; mode = 1; off = up * 128; }
            else if (it < 2 * I_GU + I_DN) { it -= 2 * I_GU; W = inp(5) + wo; WT = (bf16*)(ws + OFF_WD1 + l * SZ_WD); K = DFF; N = D; ldw = D; }
            else if (it < 4 * I_GU + I_DN) { it -= 2 * I_GU + I_DN; const int up = it >= I_GU; it -= up * I_GU; W = (up ? inp(9) : inp(8)) + wo; gain = inp(7) + l * D; WT = (bf16*)(ws + OFF_WGU2 + l * SZ_WGU); K = D; N = DFF; ldw = DFF; mode = 1; off = up * 128; }
            else if (it < 4 * I_GU + 2 * I_DN) { it -= 4 * I_GU + I_DN; W = inp(10) + wo; WT = (bf16*)(ws + OFF_WD2 + l * SZ_WD); K = DFF; N = D; ldw = D; }
            else if (it < 4 * I_GU + 2 * I_DN + I_PG) { it -= 4 * I_GU + 2 * I_DN; W = inp(12) + (size_t)l * D * D; gain = inp(11) + l * D; WT = (bf16*)(ws + OFF_WPG + l * SZ_WPG); K = D; N = D; ldw = D; }
            else { it -= 4 * I_GU + 2 * I_DN + I_PG; W = inp(13) + (size_t)l * DPLE * D; WT = (bf16*)(ws + OFF_WPP + l * SZ_WPP); K = DPLE; N = D; ldw = D; }
        } else {
            it -= 2 * I_LAYER;
            if (it < I_IN0) { W = inp(14); gain = inp(6); WT = (bf16*)(ws + OFF_WIN0); K = D; N = NIN0; ldw = NIN0; }
            else if (it < I_IN0 + I_OUT0) { it -= I_IN0; W = inp(29); WT = (bf16*)(ws + OFF_WOUT0); K = D; N = D; ldw = D; }
            else if (it < I_IN0 + I_OUT0 + I_SIN) { it -= I_IN0 + I_OUT0; W = inp(30); gain = inp(6) + D; WT = (bf16*)(ws + OFF_WSIN); K = D; N = DH; ldw = DH; }
            else { it -= I_IN0 + I_OUT0 + I_SIN; const int gt = it >= I_SOUT; it -= gt * I_SOUT; W = inp(39) + gt * D; WT = (bf16*)(ws + OFF_WSOUT); K = DH; N = D; ldw = 2 * D; mode = 1; off = gt * 128; }
        }
        conv_item(W, gain, WT, K, N / 32, ldw, mode, off, scr, it, lane);
    }
    bf16* hb = (bf16*)(ws + OFF_HB); float* ss = (float*)(ws + OFF_SS); bf16* pb = (bf16*)(ws + OFF_PB);
    const float* x = inp(0); const float* p = inp(1);
    for (int m = gw; m < M; m += NGW) {
        const f32x4* xr = (const f32x4*)(x + (size_t)m * D) + lane; float s = 0.f;
        u32x2* o = (u32x2*)(hb + (size_t)m * D) + lane;
#pragma unroll
        for (int j = 0; j < 8; ++j) { const f32x4 v = xr[64 * j]; s += (v.x * v.x + v.y * v.y) + (v.z * v.z + v.w * v.w); u32x2 w; w.x = cvtpk(v.x, v.y); w.y = cvtpk(v.z, v.w); o[64 * j] = w; }
        s = wave_sum(s);
        if (lane < 8) ss[(size_t)lane * M + m] = (lane == 0) ? s : 0.f;
    }
    for (int m = gw; m < 2 * M; m += NGW) {
        const f32x4 v = ((const f32x4*)(p + (size_t)m * DPLE))[lane]; u32x2 w; w.x = cvtpk(v.x, v.y); w.y = cvtpk(v.z, v.w);
        ((u32x2*)(pb + (size_t)m * DPLE))[lane] = w;
    }
}

using pg8::Unit;
struct EpiSwiGLU {
    static constexpr bool PERM = true, AFTER_DRAIN = false;
    bf16* ACT; const float* ss;
    __device__ __forceinline__ void operator()(const f32x4 (&acc)[2][2][4][2], const Unit& u, int wr, int wc, int fr, int fq) const {
        const int row0 = u.pm * 256 + wr * 64 + fr, col0 = u.pn * 128 + wc * 32 + 8 * fq;
#pragma unroll
        for (int ai = 0; ai < 2; ++ai)
#pragma unroll
            for (int m = 0; m < 4; ++m) {
                const int row = row0 + ai * 128 + m * 16;
                const float r = __builtin_amdgcn_rsqf(ss[row] * (1.0f / D) + RMS_EPS);
                float o[8];
#pragma unroll
                for (int n = 0; n < 2; ++n)
#pragma unroll
                    for (int j = 0; j < 4; ++j) { const float g = acc[ai][0][m][n][j] * r, uu = acc[ai][1][m][n][j] * r; o[4 * n + j] = g * fast_sigmoid(g) * uu; }
                u32x4 w; w.x = cvtpk(o[0], o[1]); w.y = cvtpk(o[2], o[3]); w.z = cvtpk(o[4], o[5]); w.w = cvtpk(o[6], o[7]);
                *(u32x4*)(ACT + (size_t)row * DFF + col0) = w;
            }
    }
};
template <int MODE> struct EpiRes {
    static constexpr bool PERM = true, AFTER_DRAIN = false;
    const float* hin; float* hout; bf16* hb; float* ssn; float scale; const float* ssc; const bf16* pp;
    __device__ __forceinline__ void operator()(const f32x4 (&acc)[2][2][4][2], const Unit& u, int wr, int wc, int fr, int fq) const {
        const int row0 = u.pm * 256 + wr * 64 + fr;
#pragma unroll
        for (int ai = 0; ai < 2; ++ai)
#pragma unroll
            for (int m = 0; m < 4; ++m) {
                const int row = row0 + ai * 128 + m * 16;
                float r = 1.f; if (MODE == 2) r = __builtin_amdgcn_rsqf(ssc[row] * (1.0f / D) + RMS_EPS);
                float sq = 0.f;
#pragma unroll
                for (int bj = 0; bj < (MODE == 1 ? 1 : 2); ++bj) {
                    const int col = (MODE == 1) ? (u.pn * 128 + wc * 32 + 8 * fq) : (u.pn * 256 + bj * 128 + wc * 32 + 8 * fq);
                    const size_t idx = (size_t)row * D + col;
                    f32x4 h0 = *(const f32x4*)(hin + idx), h1 = *(const f32x4*)(hin + idx + 4);
                    f32x4 v0, v1;
                    if (MODE == 0) { v0 = acc[ai][bj][m][0] * scale; v1 = acc[ai][bj][m][1] * scale; }
                    else if (MODE == 1) {
#pragma unroll
                        for (int j = 0; j < 4; ++j) { v0[j] = acc[ai][0][m][0][j] * fast_sigmoid(acc[ai][1][m][0][j]); v1[j] = acc[ai][0][m][1][j] * fast_sigmoid(acc[ai][1][m][1][j]); }
                    } else {
                        const u32x4 pw = *(const u32x4*)(pp + idx);
                        const float pv[8] = {bflo(pw.x), bfhi(pw.x), bflo(pw.y), bfhi(pw.y), bflo(pw.z), bfhi(pw.z), bflo(pw.w), bfhi(pw.w)};
#pragma unroll
                        for (int j = 0; j < 4; ++j) { v0[j] = fast_sigmoid(acc[ai][bj][m][0][j] * r) * pv[j]; v1[j] = fast_sigmoid(acc[ai][bj][m][1][j] * r) * pv[4 + j]; }
                    }
                    h0 += v0; h1 += v1;
                    *(f32x4*)(hout + idx) = h0; *(f32x4*)(hout + idx + 4) = h1;
                    u32x4 w; w.x = cvtpk(h0[0], h0[1]); w.y = cvtpk(h0[2], h0[3]); w.z = cvtpk(h1[0], h1[1]); w.w = cvtpk(h1[2], h1[3]);
                    *(u32x4*)(hb + idx) = w;
                    sq += (h0[0] * h0[0] + h0[1] * h0[1]) + (h0[2] * h0[2] + h0[3] * h0[3]) + (h1[0] * h1[0] + h1[1] * h1[1]) + (h1[2] * h1[2] + h1[3] * h1[3]);
                }
                sq += __shfl_xor(sq, 16); sq += __shfl_xor(sq, 32);
                if (fq == 0 && ssn) atomicAdd(ssn + row, sq);
            }
    }
};
template <bool LAYER0> struct EpiStore {
    static constexpr bool PERM = true, AFTER_DRAIN = false;
    const float* ss; bf16* O; int ldo; bf16 *QB, *KB, *VT, *Z;
    __device__ __forceinline__ void operator()(const f32x4 (&acc)[2][2][4][2], const Unit& u, int wr, int wc, int fr, int fq) const {
        const int row0 = u.pm * 256 + wr * 64 + fr;
#pragma unroll
        for (int ai = 0; ai < 2; ++ai)
#pragma unroll
            for (int m = 0; m < 4; ++m) {
                const int row = row0 + ai * 128 + m * 16;
                const float r = ss ? __builtin_amdgcn_rsqf(ss[row] * (1.0f / D) + RMS_EPS) : 1.f;
#pragma unroll
                for (int bj = 0; bj < 2; ++bj) {
                    const f32x4 v0 = acc[ai][bj][m][0] * r, v1 = acc[ai][bj][m][1] * r;
                    const int cl = bj * 128 + wc * 32 + 8 * fq;
                    if (LAYER0 && u.pn >= 8 && u.pn < 12) {
                        const int b = row >> 12, t = row & 4095, ch = (u.pn - 8) * 256 + cl;
                        bf16* vp = VT + ((size_t)(b * DH + ch)) * T + t;
                        const unsigned p0 = cvtpk(v0[0], v0[1]), p1 = cvtpk(v0[2], v0[3]), p2 = cvtpk(v1[0], v1[1]), p3 = cvtpk(v1[2], v1[3]);
                        vp[0 * (size_t)T] = (bf16)(p0 & 0xffff); vp[1 * (size_t)T] = (bf16)(p0 >> 16); vp[2 * (size_t)T] = (bf16)(p1 & 0xffff); vp[3 * (size_t)T] = (bf16)(p1 >> 16);
                        vp[4 * (size_t)T] = (bf16)(p2 & 0xffff); vp[5 * (size_t)T] = (bf16)(p2 >> 16); vp[6 * (size_t)T] = (bf16)(p3 & 0xffff); vp[7 * (size_t)T] = (bf16)(p3 >> 16);
                    } else {
                        bf16* dst;
                        if (LAYER0) {
                            if (u.pn < 4) dst = QB + (size_t)row * DH + u.pn * 256 + cl;
                            else if (u.pn < 8) dst = KB + (size_t)row * DH + (u.pn - 4) * 256 + cl;
                            else dst = Z + (size_t)row * NZ + (u.pn - 12) * 256 + cl;
                        } else dst = O + (size_t)row * ldo + u.pn * 256 + cl;
                        u32x4 w; w.x = cvtpk(v0[0], v0[1]); w.y = cvtpk(v0[2], v0[3]); w.z = cvtpk(v1[0], v1[1]); w.w = cvtpk(v1[2], v1[3]);
                        *(u32x4*)dst = w;
                    }
                }
            }
    }
};
__device__ __forceinline__ int opq(int v) { asm volatile("" : "+s"(v)); return v; }
__device__ __forceinline__ int opqv(int v) { asm volatile("" : "+v"(v)); return v; }
__device__ __forceinline__ unsigned char* wsp(unsigned char* ws, size_t off) { asm volatile("" : "+s"(ws)); return ws + off; }
#define GEMM_PHASE(EPI, Aptr, Bptr, NN, KK, Eobj) do { pg8::Gemm g_{(const pg8::bf16_t*)(Aptr), (const pg8::bf16_t*)(Bptr), M, (NN), (KK)}; pg8::StaticOrder S_; S_.init(M, (NN), opq((int)gridDim.x), opq((int)blockIdx.x)); \
        pg8::gemm_phase<EPI, pg8::StaticOrder, true, true>(lds, g_, S_, (Eobj)); } while (0)

constexpr size_t OFF_YRAW = OFF_QB;
constexpr size_t OFF_GG = OFF_VT;
constexpr size_t OFF_BV = OFF_HB;
constexpr int RECF = 384;
static_assert((size_t)2 * NB * 16 * SEGT * RECF * 4 <= 2 * SZ_SCANSEG, "segment buffers fit");

__device__ __forceinline__ float quad_sum(float v) {
    v += __builtin_bit_cast(float, __builtin_amdgcn_mov_dpp(__builtin_bit_cast(int, v), 0xB1, 0xF, 0xF, true));
    v += __builtin_bit_cast(float, __builtin_amdgcn_mov_dpp(__builtin_bit_cast(int, v), 0x4E, 0xF, 0xF, true));
    return v;
}
__device__ __forceinline__ void unpack8(const u32x4 w, float* x) { x[0] = bflo(w.x); x[1] = bfhi(w.x); x[2] = bflo(w.y); x[3] = bfhi(w.y); x[4] = bflo(w.z); x[5] = bfhi(w.z); x[6] = bflo(w.w); x[7] = bfhi(w.w); }

__device__ __forceinline__ void qknorm_rows(bf16* QBp, bf16* KBp, int gw, int NGW, int lane) {
    const float* qg = inp(15); const float* kg = inp(16);
    const int d0 = (lane & 3) * 16;
    float gq[16], gk[16];
#pragma unroll
    for (int i = 0; i < 16; ++i) { gq[i] = qg[d0 + i] * 0.125f; gk[i] = kg[d0 + i]; }
    for (int it = gw; it < 2 * M; it += NGW) {
        const bool isk = it >= M; const int row = isk ? it - M : it;
        bf16* p = (isk ? KBp : QBp) + (size_t)row * DH + lane * 16;
        float x[16]; unpack8(*(const u32x4*)p, x); unpack8(*(const u32x4*)(p + 8), x + 8);
        float s = 0.f;
#pragma unroll
        for (int i = 0; i < 16; ++i) s += x[i] * x[i];
        s = quad_sum(s);
        const float rs = __builtin_amdgcn_rsqf(s * (1.0f / 64.0f) + RMS_EPS);
#pragma unroll
        for (int i = 0; i < 16; ++i) x[i] = x[i] * rs * (isk ? gk[i] : gq[i]);
        u32x4 a, b2; a.x = cvtpk(x[0], x[1]); a.y = cvtpk(x[2], x[3]); a.z = cvtpk(x[4], x[5]); a.w = cvtpk(x[6], x[7]);
        b2.x = cvtpk(x[8], x[9]); b2.y = cvtpk(x[10], x[11]); b2.z = cvtpk(x[12], x[13]); b2.w = cvtpk(x[14], x[15]);
        *(u32x4*)p = a; *(u32x4*)(p + 8) = b2;
    }
}

#define MFMA32(a, b, c) __builtin_amdgcn_mfma_f32_32x32x16_bf16((a), (b), (c), 0, 0, 0)
__device__ __forceinline__ int crow(int i, int hh) { return (i & 3) + 8 * (i >> 2) + 4 * hh; }
__device__ __forceinline__ void attn_unit(const bf16* QBp, const bf16* KBp, const bf16* VTp, bf16* MIXp, const float* biasg, int unit, int lane) {
    const int h = unit & 15, c = (unit >> 4) & 63, b = unit >> 10;
    const int r = lane & 31, hh = lane >> 5;
    const float* bias = biasg + h * 192;
    const size_t rowq0 = (size_t)b * T + c * 64;
    bf16x8 qf[2][4];
#pragma unroll
    for (int qt = 0; qt < 2; ++qt)
#pragma unroll
        for (int s = 0; s < 4; ++s) qf[qt][s] = *(const bf16x8*)(QBp + (rowq0 + 32 * qt + r) * DH + h * 64 + 16 * s + 8 * hh);
    f32x16 oacc[2][2];
#pragma unroll
    for (int a = 0; a < 2; ++a)
#pragma unroll
        for (int q = 0; q < 2; ++q)
#pragma unroll
            for (int i = 0; i < 16; ++i) oacc[a][q][i] = 0.f;
    float mrun[2] = {-1e30f, -1e30f}, lrun[2] = {0.f, 0.f};
    const float bconst = bias[191];
    for (int kc = (c < 8 ? 8 - c : 0); kc <= 8; ++kc) {
        const int kch = c - 8 + kc;
        for (int kt = 0; kt < 2; ++kt) {
            const size_t krow = (size_t)b * T + kch * 64 + kt * 32 + r;
            bf16x8 kf[4];
#pragma unroll
            for (int s = 0; s < 4; ++s) kf[s] = *(const bf16x8*)(KBp + krow * DH + h * 64 + 16 * s + 8 * hh);
            bf16x8 vf[2][2];
#pragma unroll
            for (int dt = 0; dt < 2; ++dt)
#pragma unroll
                for (int s2 = 0; s2 < 2; ++s2) {
                    const bf16* vp = VTp + ((size_t)(b * DH + h * 64 + 32 * dt + r)) * T + kch * 64 + kt * 32 + 16 * s2 + 4 * hh;
                    const s16x4 lo = *(const s16x4*)vp, hi = *(const s16x4*)(vp + 8);
                    vf[dt][s2] = (bf16x8){lo[0], lo[1], lo[2], lo[3], hi[0], hi[1], hi[2], hi[3]};
                }
#pragma unroll
            for (int qt = 0; qt < 2; ++qt) {
                f32x16 st;
#pragma unroll
                for (int i = 0; i < 16; ++i) st[i] = 0.f;
#pragma unroll
                for (int s = 0; s < 4; ++s) st = MFMA32(kf[s], qf[qt][s], st);
                if (kc <= 5) {
#pragma unroll
                    for (int i = 0; i < 16; ++i) st[i] += bconst;
                } else {
#pragma unroll
                    for (int i = 0; i < 16; ++i) { int dist = (32 * qt + r) - (kt * 32 + crow(i, hh)) + 64 * (8 - kc); dist = dist < -63 ? -63 : (dist > 128 ? 128 : dist); st[i] += bias[dist + 63]; }
                }
                float mx = st[0];
#pragma unroll
                for (int i = 1; i < 16; ++i) mx = fmaxf(mx, st[i]);
                mx = fmaxf(mx, __shfl_xor(mx, 32));
                const float mnew = fmaxf(mrun[qt], mx), alpha = __expf(mrun[qt] - mnew);
                float ls = 0.f;
#pragma unroll
                for (int i = 0; i < 16; ++i) { st[i] = __expf(st[i] - mnew); ls += st[i]; }
                ls += __shfl_xor(ls, 32);
                lrun[qt] = lrun[qt] * alpha + ls; mrun[qt] = mnew;
#pragma unroll
                for (int dt = 0; dt < 2; ++dt)
#pragma unroll
                    for (int i = 0; i < 16; ++i) oacc[dt][qt][i] *= alpha;
                bf16x8 pk[2];
#pragma unroll
                for (int s2 = 0; s2 < 2; ++s2) { u32x4 w; w.x = cvtpk(st[8 * s2], st[8 * s2 + 1]); w.y = cvtpk(st[8 * s2 + 2], st[8 * s2 + 3]); w.z = cvtpk(st[8 * s2 + 4], st[8 * s2 + 5]); w.w = cvtpk(st[8 * s2 + 6], st[8 * s2 + 7]); pk[s2] = __builtin_bit_cast(bf16x8, w); }
#pragma unroll
                for (int dt = 0; dt < 2; ++dt)
#pragma unroll
                    for (int s2 = 0; s2 < 2; ++s2) oacc[dt][qt] = MFMA32(vf[dt][s2], pk[s2], oacc[dt][qt]);
            }
        }
    }
#pragma unroll
    for (int qt = 0; qt < 2; ++qt) {
        const float inv = 1.0f / lrun[qt];
        bf16* orow = MIXp + (rowq0 + 32 * qt + r) * D + h * 64;
#pragma unroll
        for (int dt = 0; dt < 2; ++dt)
#pragma unroll
            for (int g4 = 0; g4 < 4; ++g4) { u32x2 w; w.x = cvtpk(oacc[dt][qt][4 * g4] * inv, oacc[dt][qt][4 * g4 + 1] * inv); w.y = cvtpk(oacc[dt][qt][4 * g4 + 2] * inv, oacc[dt][qt][4 * g4 + 3] * inv);
                *(u32x2*)(orow + 32 * dt + 8 * g4 + 4 * hh) = w; }
    }
}

constexpr int PREP_TB = 16, PREP_ITEMS = NB * (SEGT / PREP_TB) * 4;
__device__ __forceinline__ void prep_item(const bf16* Zp, float* SEGp, bf16* GGp, bf16* BVp, LAS unsigned char* lds, int seg, int item, int tid) {
    const int cq = item & 3, tb = (item >> 2) % (SEGT / PREP_TB), b = item / (4 * (SEGT / PREP_TB));
    const int t0 = seg * SEGT + tb * PREP_TB;
    LAS float* LX = (LAS float*)lds;
    const float* mu = inp(18);
    {
        const int tk = tid >> 5, col8 = (tid & 31) * 8, t = t0 + tk; const size_t row = (size_t)b * T + t;
        float z[8], zp[8];
        unpack8(*(const u32x4*)(Zp + row * NZ + 3072 + col8), z);
        if (t > 0) unpack8(*(const u32x4*)(Zp + (row - 1) * NZ + 3072 + col8), zp); else {
#pragma unroll
            for (int e = 0; e < 8; ++e) zp[e] = 0.f; }
#pragma unroll
        for (int e = 0; e < 8; ++e) { float x = z[e] + (zp[e] - z[e]) * mu[3072 + col8 + e];
            if (col8 < 64) x = 1.f - 2.f * __builtin_amdgcn_rcpf(__expf(2.f * x) + 1.f); else if (col8 >= 128) x = fast_sigmoid(x);
            LX[tk * 256 + col8 + e] = x; }
    }
    __syncthreads();
    const int chl = tid & 255, th = tid >> 8, c = cq * 256 + chl, head = c >> 6, i = c & 63;
    float accw[8], acca[8], accg[8];
#pragma unroll
    for (int k = 0; k < 8; ++k) { accw[k] = 0.f; acca[k] = 0.f; accg[k] = 0.f; }
    { const float* wup = inp(20) + c;
#pragma unroll 2
      for (int j = 0; j < 64; j += 4) { const float w0 = wup[(size_t)j * DH], w1 = wup[(size_t)(j + 1) * DH], w2 = wup[(size_t)(j + 2) * DH], w3 = wup[(size_t)(j + 3) * DH];
#pragma unroll
        for (int k = 0; k < 8; ++k) { const f32x4 x = *(const LAS f32x4*)(LX + (th * 8 + k) * 256 + j); accw[k] += x[0] * w0 + x[1] * w1 + x[2] * w2 + x[3] * w3; } } }
    { const float* aup = inp(22) + c;
#pragma unroll 2
      for (int j = 0; j < 64; j += 4) { const float w0 = aup[(size_t)j * DH], w1 = aup[(size_t)(j + 1) * DH], w2 = aup[(size_t)(j + 2) * DH], w3 = aup[(size_t)(j + 3) * DH];
#pragma unroll
        for (int k = 0; k < 8; ++k) { const f32x4 x = *(const LAS f32x4*)(LX + (th * 8 + k) * 256 + 64 + j); acca[k] += x[0] * w0 + x[1] * w1 + x[2] * w2 + x[3] * w3; } } }
    { const float* gup = inp(23) + c;
#pragma unroll 2
      for (int j = 0; j < 128; j += 4) { const float w0 = gup[(size_t)j * DH], w1 = gup[(size_t)(j + 1) * DH], w2 = gup[(size_t)(j + 2) * DH], w3 = gup[(size_t)(j + 3) * DH];
#pragma unroll
        for (int k = 0; k < 8; ++k) { const f32x4 x = *(const LAS f32x4*)(LX + (th * 8 + k) * 256 + 128 + j); accg[k] += x[0] * w0 + x[1] * w1 + x[2] * w2 + x[3] * w3; } } }
    const float mur = mu[c], muk = mu[DH + c], muv = mu[2 * DH + c];
    const float w0c = inp(19)[c], a0c = inp(21)[c], kkc = inp(24)[c], kac = inp(25)[c], rkc = inp(26)[c];
    float zr_p, zk_p, zv_p;
    { const int t = t0 + th * 8; const size_t row = (size_t)b * T + t;
      if (t > 0) { zr_p = bf2f(Zp[(row - 1) * NZ + c]); zk_p = bf2f(Zp[(row - 1) * NZ + DH + c]); zv_p = bf2f(Zp[(row - 1) * NZ + 2 * DH + c]); } else { zr_p = 0.f; zk_p = 0.f; zv_p = 0.f; } }
#pragma unroll
    for (int k = 0; k < 8; ++k) {
        const int t = t0 + th * 8 + k; const size_t row = (size_t)b * T + t;
        const float zr = bf2f(Zp[row * NZ + c]), zk = bf2f(Zp[row * NZ + DH + c]), zv = bf2f(Zp[row * NZ + 2 * DH + c]);
        const float rr = zr + (zr_p - zr) * mur, kk0 = zk + (zk_p - zk) * muk, vv = zv + (zv_p - zv) * muv;
        zr_p = zr; zk_p = zk; zv_p = zv;
        const float wl = -(w0c + accw[k]);
        const float sp = fmaxf(wl, 0.f) + __logf(1.f + __expf(-fabsf(wl)));
        const float decay = __expf(-__expf(-sp - 0.5f));
        const float a = fast_sigmoid(a0c + acca[k]);
        float kk = kk0 * kkc; const float n2 = wave_sum(kk * kk); kk = kk / fmaxf(sqrtf(n2), 1e-12f);
        const float kp = kk0 * (1.f + (a - 1.f) * kac);
        const float bonus = wave_sum(rr * kp * rkc);
        float* rec = SEGp + ((size_t)((((seg & 1) * NB + b) * 16 + head) * SEGT + (t - seg * SEGT))) * RECF;
        rec[i] = -kk; rec[64 + i] = decay; rec[128 + i] = kk * a; rec[192 + i] = kp; rec[256 + i] = rr; rec[320 + i] = vv;
        GGp[row * DH + c] = (bf16)(cvtpk(accg[k], 0.f) & 0xffff); BVp[row * DH + c] = (bf16)(cvtpk(bonus * vv, 0.f) & 0xffff);
    }
    __syncthreads();
}

#define SCAN_BAR() asm volatile("s_waitcnt lgkmcnt(0)\n\ts_barrier" ::: "memory")
__device__ __forceinline__ void scan_segment(const float* SEGp, float* Yp, LAS unsigned char* lds, int seg, int blk, int tid, f32x2& S) {
    const int lane = tid & 63, wv = tid >> 6, kq = lane & 3, rl = lane >> 2;
    const int b = blk >> 6, h = (blk >> 2) & 15, rg = blk & 3;
    LAS float* RING = (LAS float*)lds;
    LAS float* SACC = RING + 16 * 336;
    LAS float* YACC = SACC + 48;
    const float* recs = SEGp + ((size_t)((((seg & 1) * NB + b) * 16 + h) * SEGT)) * RECF;
    const int k0 = kq * 16 + wv * 2;
    if (tid < 48) SACC[tid] = 0.f;
    if (tid < 256) YACC[tid] = 0.f;
    { const float* rp = recs + (size_t)wv * RECF;
#pragma unroll
      for (int j = 0; j < 5; ++j) RING[wv * 336 + j * 64 + lane] = rp[j * 64 + lane];
      if (lane < 16) RING[wv * 336 + 320 + lane] = rp[320 + rg * 16 + lane]; }
    __syncthreads();
    constexpr int NBATCH = SEGT / 8;
    for (int B = 0; B < NBATCH; ++B) {
        float pf[5], pfv = 0.f;
        const bool more = (B + 1 < NBATCH);
        if (more) { const float* rp = recs + (size_t)(8 * (B + 1) + wv) * RECF;
#pragma unroll
            for (int j = 0; j < 5; ++j) pf[j] = rp[j * 64 + lane];
            if (lane < 16) pfv = rp[320 + rg * 16 + lane]; }
#pragma unroll
        for (int j = 0; j < 8; ++j) {
            const int t = 8 * B + j, slot = (B & 1) * 8 + j;
            const LAS float* sl = RING + slot * 336;
            const f32x2 nkk2 = *(const LAS f32x2*)(sl + k0), w2 = *(const LAS f32x2*)(sl + 64 + k0), ib2 = *(const LAS f32x2*)(sl + 128 + k0),
                        kp2 = *(const LAS f32x2*)(sl + 192 + k0), r2 = *(const LAS f32x2*)(sl + 256 + k0);
            const float vv = sl[320 + rl];
            const float saq = quad_sum(nkk2.x * S.x + nkk2.y * S.y);
            const int sb = t % 3;
            if (kq == 0) __hip_atomic_fetch_add(SACC + sb * 16 + rl, saq, __ATOMIC_RELAXED, __HIP_MEMORY_SCOPE_WORKGROUP);
            if (tid < 16) SACC[((t + 1) % 3) * 16 + tid] = 0.f;
            if (j == 7 && more) {
#pragma unroll
                for (int q = 0; q < 5; ++q) RING[(((B + 1) & 1) * 8 + wv) * 336 + q * 64 + lane] = pf[q];
                if (lane < 16) RING[(((B + 1) & 1) * 8 + wv) * 336 + 320 + lane] = pfv;
            }
            SCAN_BAR();
            if (j == 0 && B > 0 && lane < 16) {
                const int ps = ((B - 1) & 1) * 8 + wv;
                Yp[((size_t)b * T + seg * SEGT + 8 * (B - 1) + wv) * DH + h * 64 + rg * 16 + lane] = YACC[ps * 16 + lane];
                YACC[ps * 16 + lane] = 0.f;
            }
            const float sa = SACC[sb * 16 + rl];
            S = S * w2 + sa * ib2 + vv * kp2;
            const float yq = quad_sum(r2.x * S.x + r2.y * S.y);
            if (kq == 0) __hip_atomic_fetch_add(YACC + slot * 16 + rl, yq, __ATOMIC_RELAXED, __HIP_MEMORY_SCOPE_WORKGROUP);
        }
    }
    SCAN_BAR();
    if (lane < 16) { const int ps = ((NBATCH - 1) & 1) * 8 + wv;
        Yp[((size_t)b * T + seg * SEGT + 8 * (NBATCH - 1) + wv) * DH + h * 64 + rg * 16 + lane] = YACC[ps * 16 + lane]; }
    __syncthreads();
}

__device__ __forceinline__ void rwkv_post(const float* Yp, const bf16* GGp, const bf16* BVp, bf16* MIXp, int gw, int NGW, int lane) {
    const float* lw = inp(27); const float* lb = inp(28);
    for (int it = gw; it < M * 16; it += NGW) {
        const int row = it >> 4, c = (it & 15) * 64 + lane;
        const float y = Yp[(size_t)row * DH + c];
        const float mean = wave_sum(y) * (1.0f / 64.0f), dlt = y - mean;
        const float var = wave_sum(dlt * dlt) * (1.0f / 64.0f);
        const float yn = dlt * __builtin_amdgcn_rsqf(var + 64e-5f);
        const float o = (yn * lw[c] + lb[c] + bf2f(BVp[(size_t)row * DH + c])) * bf2f(GGp[(size_t)row * DH + c]);
        MIXp[(size_t)row * D + DH + c] = (bf16)(cvtpk(o, 0.f) & 0xffff);
    }
}

__device__ __forceinline__ float gelu_tanh(float x) {
    const float t = 0.7978845608028654f * (x + 0.044715f * x * x * x);
    const float e = __expf(2.f * t);
    const float th = 1.f - 2.f * __builtin_amdgcn_rcpf(e + 1.f);
    return 0.5f * x * (1.f + th);
}
__device__ __forceinline__ void s5_unit(const bf16* U, bf16* YS, LAS unsigned char* lds, int b, int g, int tid) {
    const int lane = tid & 63, seg = tid >> 6;
    LAS float* us = (LAS float*)lds;
    LAS float* E = us + 64 * 16;
    LAS float* CAR = E + 8 * 64 * 2;
    LAS float* Hre = CAR + 128;
    LAS float* Him = Hre + 64 * 65;
    LAS float* CRE = Him + 64 * 65;
    LAS float* CIM = CRE + 16 * 64;
    const int p = lane;
    const float* bre_p = inp(34); const float* bim_p = inp(35); const float* cre_p = inp(36); const float* cim_p = inp(37); const float* dsk_p = inp(38);
    const float lr = inp(31)[g * 64 + p], li = inp(32)[g * 64 + p], dt = expf(inp(33)[g]);
    const float mag = expf(lr * dt), are = mag * cosf(li * dt), aim = mag * sinf(li * dt);
    const float den = lr * lr + li * li;
    const float zre = ((are - 1.f) * lr + aim * li) / den, zim = (aim * lr - (are - 1.f) * li) / den;
    float bbr[16], bbi[16];
#pragma unroll
    for (int c = 0; c < 16; ++c) { const float br = bre_p[(g * 64 + p) * 16 + c], bi = bim_p[(g * 64 + p) * 16 + c]; bbr[c] = zre * br - zim * bi; bbi[c] = zre * bi + zim * br; }
    float pwr[8], pwi[8];
    pwr[0] = are; pwi[0] = aim;
#pragma unroll
    for (int j = 1; j < 8; ++j) { pwr[j] = pwr[j - 1] * are - pwi[j - 1] * aim; pwi[j] = pwr[j - 1] * aim + pwi[j - 1] * are; }
    for (int i = tid; i < 16 * 64; i += NTHREADS) { CRE[i] = cre_p[g * 1024 + i]; CIM[i] = cim_p[g * 1024 + i]; }
    if (tid < 64) { CAR[2 * tid] = 0.f; CAR[2 * tid + 1] = 0.f; }
    const int c0 = 2 * seg;
    const float d0 = dsk_p[g * 16 + c0], d1 = dsk_p[g * 16 + c0 + 1];
    __syncthreads();
    for (int ch = 0; ch < T / 64; ++ch) {
        const int row0 = b * T + ch * 64;
        if (tid < 128) {
            const int t = tid >> 1, hf = tid & 1;
            const u32x4 w = *(const u32x4*)(U + (size_t)(row0 + t) * DH + g * 16 + hf * 8);
            LAS float* d = us + t * 16 + hf * 8;
            d[0] = bflo(w.x); d[1] = bfhi(w.x); d[2] = bflo(w.y); d[3] = bfhi(w.y); d[4] = bflo(w.z); d[5] = bfhi(w.z); d[6] = bflo(w.w); d[7] = bfhi(w.w);
        }
        __syncthreads();
        float hr[8], hi[8]; float sr = 0.f, si = 0.f;
#pragma unroll
        for (int j = 0; j < 8; ++j) {
            const LAS f32x4* up = (const LAS f32x4*)(us + (seg * 8 + j) * 16);
            float br = 0.f, bi = 0.f;
#pragma unroll
            for (int q = 0; q < 4; ++q) { const f32x4 uv = up[q];
#pragma unroll
                for (int e = 0; e < 4; ++e) { br += bbr[4 * q + e] * uv[e]; bi += bbi[4 * q + e] * uv[e]; } }
            const float nr = are * sr - aim * si + br, ni = are * si + aim * sr + bi;
            sr = nr; si = ni; hr[j] = sr; hi[j] = si;
        }
        E[(seg * 64 + p) * 2] = sr; E[(seg * 64 + p) * 2 + 1] = si;
        __syncthreads();
        float cr = CAR[2 * p], ci = CAR[2 * p + 1];
        for (int s = 0; s < seg; ++s) { const float er = E[(s * 64 + p) * 2], ei = E[(s * 64 + p) * 2 + 1];
            const float nr = pwr[7] * cr - pwi[7] * ci + er, ni = pwr[7] * ci + pwi[7] * cr + ei; cr = nr; ci = ni; }
#pragma unroll
        for (int j = 0; j < 8; ++j) {
            const float fr_ = hr[j] + pwr[j] * cr - pwi[j] * ci, fi_ = hi[j] + pwr[j] * ci + pwi[j] * cr;
            Hre[(seg * 8 + j) * 65 + p] = fr_; Him[(seg * 8 + j) * 65 + p] = fi_;
            if (seg == 7 && j == 7) { hr[7] = fr_; hi[7] = fi_; }
        }
        __syncthreads();
        if (seg == 7) { CAR[2 * p] = hr[7]; CAR[2 * p + 1] = hi[7]; }
        {
            const int t = lane;
            float y0 = 0.f, y1 = 0.f;
#pragma unroll 4
            for (int q = 0; q < 64; q += 4) {
                const f32x4 cr0 = *(const LAS f32x4*)(CRE + c0 * 64 + q), ci0 = *(const LAS f32x4*)(CIM + c0 * 64 + q);
                const f32x4 cr1 = *(const LAS f32x4*)(CRE + (c0 + 1) * 64 + q), ci1 = *(const LAS f32x4*)(CIM + (c0 + 1) * 64 + q);
#pragma unroll
                for (int e = 0; e < 4; ++e) { const float xr = Hre[t * 65 + q + e], xi = Him[t * 65 + q + e];
                    y0 += cr0[e] * xr - ci0[e] * xi; y1 += cr1[e] * xr - ci1[e] * xi; }
            }
            y0 += d0 * us[t * 16 + c0]; y1 += d1 * us[t * 16 + c0 + 1];
            *(unsigned*)(YS + (size_t)(row0 + t) * DH + g * 16 + c0) = cvtpk(gelu_tanh(y0), gelu_tanh(y1));
        }
        __syncthreads();
    }
}

__global__ void __launch_bounds__(NTHREADS, 2) fwd_megakernel(Params P) {
    extern __shared__ __attribute__((aligned(16))) unsigned char lds_raw[];
    cg::grid_group grid = cg::this_grid();
    LAS unsigned char* lds = (LAS unsigned char*)lds_raw;
    const int tid = threadIdx.x, lane = tid & 63, wave = __builtin_amdgcn_readfirstlane(tid >> 6);
    const int G = gridDim.x, bid = blockIdx.x;
    const int gw = bid * NWAVES + wave, NGW = G * NWAVES;
    unsigned char* ws = P.ws;
#define HB ((bf16*)wsp(ws, OFF_HB))
#define HB2 ((bf16*)wsp(ws, OFF_SCAN))
#define PB ((bf16*)wsp(ws, OFF_PB))
#define SSP(j) ((float*)wsp(ws, OFF_SS + (size_t)(j) * M * 4))
#define ACT ((bf16*)wsp(ws, OFF_R))
#define MIX ((bf16*)wsp(ws, OFF_MIX))
#define QB ((bf16*)wsp(ws, OFF_QB))
#define KB ((bf16*)wsp(ws, OFF_KB))
#define VT ((bf16*)wsp(ws, OFF_VT))
#define ZB ((bf16*)wsp(ws, OFF_Z))
#define UB ((bf16*)wsp(ws, OFF_U))
#define YS ((bf16*)wsp(ws, OFF_YS))
    { const int t_ = opqv((int)threadIdx.x), wv_ = __builtin_amdgcn_readfirstlane(t_ >> 6); p0_prologue(ws, lds, opq((int)blockIdx.x) * NWAVES + wv_, opq((int)gridDim.x) * NWAVES, wv_, t_ & 63); }
    grid.sync();

    for (int l = 0; l < 2; ++l) {
        const float* hin0 = (l == 0) ? inp(0) : P.out;
        { EpiSwiGLU E{ACT, SSP(4 * l)}; GEMM_PHASE(EpiSwiGLU, (l == 0) ? HB : HB2, wsp(ws, OFF_WGU1) + l * SZ_WGU, 2 * DFF, D, E); }
        grid.sync();
        { EpiRes<0> E{hin0, P.out, HB, SSP(4 * l + 1), 0.5f, nullptr, nullptr}; GEMM_PHASE(EpiRes<0>, ACT, wsp(ws, OFF_WD1) + l * SZ_WD, D, DFF, E); }
        grid.sync();
        if (l == 0) {
            { EpiStore<true> E{SSP(4 * l + 1), nullptr, 0, QB, KB, VT, ZB}; GEMM_PHASE(EpiStore<true>, HB, wsp(ws, OFF_WIN0), NIN0, D, E); }
            grid.sync();
            #define OPQ_IDS const int t_ = opqv((int)threadIdx.x), ln_ = t_ & 63, bid_ = opq((int)blockIdx.x), G_ = opq((int)gridDim.x), gw_ = bid_ * NWAVES + __builtin_amdgcn_readfirstlane(t_ >> 6), NGW_ = G_ * NWAVES; (void)ln_; (void)gw_; (void)NGW_;
            { OPQ_IDS qknorm_rows(QB, KB, gw_, NGW_, ln_); }
            grid.sync();
            { OPQ_IDS const float* biasg = inp(17); for (int un = gw_; un < NB * 64 * 16; un += NGW_) attn_unit(QB, KB, VT, MIX, biasg, un, ln_); }
            grid.sync();
            { f32x2 Sst = {0.f, 0.f};
              for (int s = 0; s <= NSEG; ++s) {
                if (s >= 1) { OPQ_IDS scan_segment((const float*)wsp(ws, OFF_SCAN), (float*)wsp(ws, OFF_YRAW), lds, s - 1, bid_, t_, Sst); }
                if (s < NSEG) { OPQ_IDS for (int it = bid_; it < PREP_ITEMS; it += G_) prep_item(ZB, (float*)wsp(ws, OFF_SCAN), (bf16*)wsp(ws, OFF_GG), (bf16*)wsp(ws, OFF_BV), lds, s, it, t_); }
                grid.sync();
              } }
            { OPQ_IDS rwkv_post((const float*)wsp(ws, OFF_YRAW), (const bf16*)wsp(ws, OFF_GG), (const bf16*)wsp(ws, OFF_BV), MIX, gw_, NGW_, ln_); }
            grid.sync();
            { EpiRes<0> E{P.out, P.out, HB, SSP(4 * l + 2), 1.0f, nullptr, nullptr}; GEMM_PHASE(EpiRes<0>, MIX, wsp(ws, OFF_WOUT0), D, D, E); }
            grid.sync();
        } else {
            { EpiStore<false> E{SSP(4 * l + 1), UB, DH, nullptr, nullptr, nullptr, nullptr}; GEMM_PHASE(EpiStore<false>, HB, wsp(ws, OFF_WSIN), DH, D, E); }
            grid.sync();
            { OPQ_IDS for (int un = bid_; un < NB * 64; un += G_) s5_unit(UB, YS, lds, un >> 6, un & 63, t_); } grid.sync();
            { EpiRes<1> E{P.out, P.out, HB, SSP(4 * l + 2), 1.0f, nullptr, nullptr}; GEMM_PHASE(EpiRes<1>, YS, wsp(ws, OFF_WSOUT), 2 * D, DH, E); }
            grid.sync();
        }
        { EpiSwiGLU E{ACT, SSP(4 * l + 2)}; GEMM_PHASE(EpiSwiGLU, HB, wsp(ws, OFF_WGU2) + l * SZ_WGU, 2 * DFF, D, E); }
        grid.sync();
        { EpiRes<0> E{P.out, P.out, HB, SSP(4 * l + 3), 0.5f, nullptr, nullptr}; GEMM_PHASE(EpiRes<0>, ACT, wsp(ws, OFF_WD2) + l * SZ_WD, D, DFF, E); }
        { EpiStore<false> E{nullptr, MIX, D, nullptr, nullptr, nullptr, nullptr}; GEMM_PHASE(EpiStore<false>, PB + (size_t)l * M * DPLE, wsp(ws, OFF_WPP) + l * SZ_WPP, D, DPLE, E); }
        grid.sync();
        { EpiRes<2> E{P.out, P.out, HB2, (l == 0) ? (SSP(4 * l + 4)) : nullptr, 1.0f, SSP(4 * l + 3), MIX}; GEMM_PHASE(EpiRes<2>, HB, wsp(ws, OFF_WPG) + l * SZ_WPG, D, D, E); }
        if (l == 0) grid.sync();
    }
}

extern "C" void kernel_launch(void* const* d_in, const int* in_sizes, int n_in, void* d_out, int out_size, void* d_ws, size_t ws_size, hipStream_t stream) {
    static int grid_blocks = 0;
    if (grid_blocks == 0) {
        int dev = 0, cus = 0, per_cu = 0;
        hipGetDevice(&dev); hipDeviceGetAttribute(&cus, hipDeviceAttributeMultiprocessorCount, dev);
        hipFuncSetAttribute((const void*)fwd_megakernel, hipFuncAttributeMaxDynamicSharedMemorySize, LDS_BYTES);
        hipOccupancyMaxActiveBlocksPerMultiprocessor(&per_cu, (const void*)fwd_megakernel, NTHREADS, LDS_BYTES);
        if (per_cu < 1) { fprintf(stderr, "occupancy query returned %d\n", per_cu); per_cu = 1; }
        grid_blocks = cus * per_cu;
        if (ws_size < WS_END) fprintf(stderr, "workspace too small: %zu < %zu\n", ws_size, (size_t)WS_END);
    }
    Params p{};
    unsigned char* ws = (unsigned char*)d_ws;
    for (int i = 0; i < 40; ++i) p.in[i] = (const float*)d_in[i];
    p.out = (float*)d_out; p.ws = ws;

    void* args[] = {&p};
    hipError_t e = hipLaunchCooperativeKernel((const void*)fwd_megakernel, dim3(grid_blocks), dim3(NTHREADS), args, LDS_BYTES, stream);
    if (e != hipSuccess) fprintf(stderr, "cooperative launch failed: %s (grid %d)\n", hipGetErrorString(e), grid_blocks);
}
```

```cpp
#include <hip/hip_runtime.h>
#include <hip/hip_cooperative_groups.h>
#include <cstdio>
#include <cstdint>
namespace cg = cooperative_groups;
namespace pg8 {
#define PG8_LAS __attribute__((address_space(3)))
typedef unsigned short bf16_t;
typedef short bf16x8 __attribute__((ext_vector_type(8)));
typedef float f32x4 __attribute__((ext_vector_type(4)));
typedef unsigned u32x4 __attribute__((ext_vector_type(4)));
constexpr int BM = 256, BK = 64, HALF = 128, HTB = HALF * BK * 2  , STAGE_BYTES = 8 * HTB, NXCD = 8, WGM = 4;

__host__ __device__ __forceinline__ int lds_byte(int r, int c) { const int st = (r >> 4) * 2 + (c >> 5), rr = r & 15, cc = c & 31, ob = rr * 64 + cc * 2; return st * 1024 + (ob ^ (((ob >> 9) & 1) << 5)); }
__host__ __device__ __forceinline__ void stage_rc(int b, int& R, int& C) { const int st = b / 1024, sb = b % 1024, swz = sb ^ (((sb >> 9) & 1) << 5); R = (st >> 1) * 16 + swz / 64; C = (st & 1) * 32 + (swz % 64) / 2; }
__host__ __device__ __forceinline__ int perm32(int rho) { const int n = rho >> 4, i = rho & 15; return 8 * (i >> 2) + 4 * n + (i & 3); }

struct Unit { int pm, pn; };
struct Gemm { const bf16_t* A; const bf16_t* Bt; int M, N, K; };

struct StaticOrder {
    int nM, nN, nwg, G, c;
    __host__ __device__ void init(int M, int N, int G_, int c_) { nM = M / BM; nN = N / BM; nwg = nM * nN; G = G_; c = c_; }
    __host__ __device__ bool next(int i, Unit& u) const {
        const long L = (long)i * G + c; if (L >= nwg) return false;
        int wgid = (int)L; { const int q = nwg / NXCD, r = nwg % NXCD, xcd = wgid % NXCD, off = wgid / NXCD; wgid = (xcd < r ? xcd * (q + 1) : r * (q + 1) + (xcd - r) * q) + off; }
        const int nig = WGM * nN, gid = wgid / nig, fm = gid * WGM, gsz = (nM - fm) < WGM ? (nM - fm) : WGM;
        u.pm = fm + ((wgid % nig) % gsz); u.pn = (wgid % nig) / gsz; return true;
    }
    __device__ __forceinline__ void a_ready(const Unit&) const {}
    __device__ __forceinline__ void done(const Unit&) const {}
};

__device__ __forceinline__ unsigned cvt_pk_bf16(float lo, float hi) { unsigned r; asm volatile("v_cvt_pk_bf16_f32 %0, %1, %2" : "=v"(r) : "v"(lo), "v"(hi)); return r; }
template <class Epi, class Sched, bool ALIGN_EPI = false, bool SP2 = false>
__device__ __forceinline__ void gemm_phase(PG8_LAS unsigned char* lds, const Gemm g, const Sched& S, const Epi& E) {
    int tid_o = threadIdx.x; asm volatile("" : "+v"(tid_o));
    const int tid = tid_o, wid = __builtin_amdgcn_readfirstlane(tid >> 6), lane = tid & 63, wr = wid >> 2, wc = wid & 3, fr = lane & 15, fq = lane >> 4;
    const int K = g.K, nt = K / BK;
    unsigned voffA[2], voffB[2];
#pragma unroll
    for (int i = 0; i < 2; ++i) { int R, C; stage_rc(tid * 16 + i * 8192, R, C); const int Rb = Epi::PERM ? ((R & ~31) + perm32(R & 31)) : R;
        voffA[i] = (unsigned)(R * K + C) * 2u; voffB[i] = (unsigned)(Rb * K + C) * 2u; }
    const size_t kstep = (size_t)(BK * 2);
    const size_t hstep = (size_t)HALF * K * 2;
    const size_t tstep = 2 * hstep;
    const unsigned ldsw = (unsigned)wid * 1024u;
    const int aoff = lds_byte(wr * 64 + fr, fq * 8), boff = lds_byte(wc * 32 + fr, fq * 8);
#define PG8_SA(b, h) (((b) * 2 + (h)) * HTB)
#define PG8_SB(b, h) ((4 + (b) * 2 + (h)) * HTB)
#define PG8_STAGE(bufoff, gbase, voff) do { _Pragma("unroll") for (int _i = 0; _i < 2; ++_i) \
        __builtin_amdgcn_global_load_lds((const unsigned*)((const char*)(gbase) + (voff)[_i]), (PG8_LAS unsigned*)(lds + (bufoff) + ldsw + _i * 8192), 16, 0, 0); } while (0)
#define PG8_LDA(dst, b, h) do { _Pragma("unroll") for (int m = 0; m < 4; ++m) _Pragma("unroll") for (int k = 0; k < 2; ++k) dst[m][k] = *(const PG8_LAS bf16x8*)(lds + PG8_SA(b, h) + aoff + m * 2048 + k * 1024); } while (0)
#define PG8_LDB(dst, b, h) do { _Pragma("unroll") for (int n = 0; n < 2; ++n) _Pragma("unroll") for (int k = 0; k < 2; ++k) dst[n][k] = *(const PG8_LAS bf16x8*)(lds + PG8_SB(b, h) + boff + n * 2048 + k * 1024); } while (0)
#define PG8_MMA(ai, bj, At, Bt) do { __builtin_amdgcn_s_setprio(1); _Pragma("unroll") for (int m = 0; m < 4; ++m) _Pragma("unroll") for (int n = 0; n < 2; ++n) _Pragma("unroll") for (int k = 0; k < 2; ++k) \
        acc[ai][bj][m][n] = __builtin_amdgcn_mfma_f32_16x16x32_bf16(Bt[n][k], At[m][k], acc[ai][bj][m][n], 0, 0, 0); __builtin_amdgcn_s_setprio(0); } while (0)
#define PG8_WAIT_V(n) asm volatile("s_waitcnt vmcnt(" #n ")" ::: "memory")
#define PG8_WAIT_L(n) asm volatile("s_waitcnt lgkmcnt(" #n ")" ::: "memory")
#define PG8_BAR __builtin_amdgcn_s_barrier()
#define PG8_SCHED __builtin_amdgcn_sched_barrier(0)
    Unit cur, nxt; int ui = 0;
    if (!S.next(0, cur)) return;
    f32x4 acc[2][2][4][2];
#pragma unroll
    for (int a = 0; a < 2; ++a)
#pragma unroll
        for (int b = 0; b < 2; ++b)
#pragma unroll
            for (int m = 0; m < 4; ++m)
#pragma unroll
                for (int n = 0; n < 2; ++n) acc[a][b][m][n] = (f32x4){0.f, 0.f, 0.f, 0.f};
    bf16x8 At[4][2], B0[2][2], B1[2][2];
    const char* cA = (const char*)g.A + (size_t)cur.pm * tstep; const char* cB = (const char*)g.Bt + (size_t)cur.pn * tstep;
    S.a_ready(cur);
    if constexpr (SP2) {
        PG8_STAGE(PG8_SB(0, 0), cB, voffB); PG8_STAGE(PG8_SB(0, 1), cB + hstep, voffB); PG8_STAGE(PG8_SA(0, 0), cA, voffA); PG8_STAGE(PG8_SA(0, 1), cA + hstep, voffA);
        if (wr == 1) PG8_BAR;
        PG8_WAIT_V(2); PG8_BAR;
        PG8_STAGE(PG8_SB(1, 0), cB + kstep, voffB); PG8_STAGE(PG8_SA(1, 0), cA + kstep, voffA); PG8_STAGE(PG8_SB(1, 1), cB + hstep + kstep, voffB);
        PG8_WAIT_V(6); PG8_BAR;
    } else {
        PG8_STAGE(PG8_SB(0, 0), cB, voffB); PG8_STAGE(PG8_SA(0, 0), cA, voffA); PG8_STAGE(PG8_SB(0, 1), cB + hstep, voffB); PG8_STAGE(PG8_SA(0, 1), cA + hstep, voffA);
        if (wr == 1) PG8_BAR;
        PG8_WAIT_V(4); PG8_BAR;
        PG8_STAGE(PG8_SB(1, 0), cB + kstep, voffB); PG8_STAGE(PG8_SA(1, 0), cA + kstep, voffA); PG8_STAGE(PG8_SB(1, 1), cB + hstep + kstep, voffB);
        PG8_WAIT_V(6); PG8_BAR;
    }
    for (;;) {
        const bool has_next = S.next(ui + 1, nxt);
        const char* nA = has_next ? (const char*)g.A + (size_t)nxt.pm * tstep : cA; const char* nB = has_next ? (const char*)g.Bt + (size_t)nxt.pn * tstep : cB;
        for (int t = 0; t < nt; t += 2) {
            const bool last = (t == nt - 2);
            const char* a1 = cA + (size_t)(t + 1) * kstep;
            const char* a2 = last ? nA : cA + (size_t)(t + 2) * kstep; const char* b2 = last ? nB : cB + (size_t)(t + 2) * kstep;
            const char* a3 = a2 + kstep; const char* b3 = b2 + kstep;
            if (last && has_next) S.a_ready(nxt);
            if constexpr (SP2) {
            PG8_LDB(B0, 0, 0); PG8_LDB(B1, 0, 1); PG8_SCHED; PG8_LDA(At, 0, 0); PG8_STAGE(PG8_SA(1, 1), a1 + hstep, voffA);
            PG8_WAIT_V(8); PG8_WAIT_L(0); PG8_BAR; PG8_MMA(0, 0, At, B0); PG8_MMA(0, 1, At, B1); PG8_BAR; PG8_SCHED;
            PG8_LDA(At, 0, 1); PG8_STAGE(PG8_SB(0, 0), b2, voffB); PG8_STAGE(PG8_SB(0, 1), b2 + hstep, voffB); PG8_STAGE(PG8_SA(0, 0), a2, voffA);
            PG8_WAIT_V(8); PG8_WAIT_L(0); PG8_BAR; PG8_MMA(1, 0, At, B0); PG8_MMA(1, 1, At, B1); PG8_BAR; PG8_SCHED;
            PG8_LDB(B0, 1, 0); PG8_LDB(B1, 1, 1); PG8_SCHED; PG8_LDA(At, 1, 0); PG8_STAGE(PG8_SA(0, 1), a2 + hstep, voffA);
            PG8_WAIT_V(8); PG8_WAIT_L(0); PG8_BAR; PG8_MMA(0, 0, At, B0); PG8_MMA(0, 1, At, B1); PG8_BAR; PG8_SCHED;
            PG8_LDA(At, 1, 1); PG8_STAGE(PG8_SB(1, 0), b3, voffB); PG8_STAGE(PG8_SB(1, 1), b3 + hstep, voffB); PG8_STAGE(PG8_SA(1, 0), a3, voffA);
            PG8_WAIT_V(8); PG8_WAIT_L(0); PG8_BAR; PG8_MMA(1, 0, At, B0); PG8_MMA(1, 1, At, B1); PG8_BAR; PG8_SCHED;
            } else {
            PG8_LDB(B0, 0, 0); PG8_SCHED; PG8_LDA(At, 0, 0); PG8_STAGE(PG8_SA(1, 1), a1 + hstep, voffA);
            PG8_WAIT_L(8); PG8_BAR; PG8_WAIT_L(0); PG8_MMA(0, 0, At, B0); PG8_BAR; PG8_SCHED;
            PG8_LDB(B1, 0, 1); PG8_STAGE(PG8_SB(0, 0), b2, voffB);
            PG8_BAR; PG8_WAIT_L(0); PG8_MMA(0, 1, At, B1); PG8_BAR;
            PG8_LDA(At, 0, 1); PG8_STAGE(PG8_SA(0, 0), a2, voffA);
            PG8_BAR; PG8_WAIT_L(0); PG8_MMA(1, 0, At, B0); PG8_BAR; PG8_SCHED;
            PG8_STAGE(PG8_SB(0, 1), b2 + hstep, voffB);
            PG8_WAIT_V(6); PG8_BAR; PG8_MMA(1, 1, At, B1); PG8_BAR;
            PG8_LDB(B0, 1, 0); PG8_SCHED; PG8_LDA(At, 1, 0); PG8_STAGE(PG8_SA(0, 1), a2 + hstep, voffA);
            PG8_WAIT_L(8); PG8_BAR; PG8_WAIT_L(0); PG8_MMA(0, 0, At, B0); PG8_BAR; PG8_SCHED;
            PG8_LDB(B1, 1, 1); PG8_STAGE(PG8_SB(1, 0), b3, voffB);
            PG8_BAR; PG8_WAIT_L(0); PG8_MMA(0, 1, At, B1); PG8_BAR;
            PG8_LDA(At, 1, 1); PG8_STAGE(PG8_SA(1, 0), a3, voffA);
            PG8_BAR; PG8_WAIT_L(0); PG8_MMA(1, 0, At, B0); PG8_BAR; PG8_SCHED;
            PG8_STAGE(PG8_SB(1, 1), b3 + hstep, voffB);
            PG8_WAIT_V(6); PG8_BAR; PG8_MMA(1, 1, At, B1); PG8_BAR;
            }
        }
        if constexpr (ALIGN_EPI) { if (wr == 0) PG8_BAR; }
        if constexpr (!Epi::AFTER_DRAIN) { E(acc, cur, wr, wc, fr, fq); S.done(cur); }
        if (!has_next) break;
#pragma unroll
        for (int a = 0; a < 2; ++a)
#pragma unroll
            for (int b = 0; b < 2; ++b)
#pragma unroll
                for (int m = 0; m < 4; ++m)
#pragma unroll
                    for (int n = 0; n < 2; ++n) acc[a][b][m][n] = (f32x4){0.f, 0.f, 0.f, 0.f};
        cur = nxt; cA = nA; cB = nB; ++ui;
        if constexpr (ALIGN_EPI) { if (wr == 1) PG8_BAR; }
    }
    PG8_WAIT_V(0);
    if constexpr (!ALIGN_EPI) { if (wr == 0) PG8_BAR; }
    PG8_BAR;
    if constexpr (Epi::AFTER_DRAIN) { E.fused(acc, cur, wr, wc, fr, fq, lds, wid, lane); S.done(cur); }
#undef PG8_SA
#undef PG8_SB
#undef PG8_STAGE
#undef PG8_LDA
#undef PG8_LDB
#undef PG8_MMA
#undef PG8_WAIT_V
#undef PG8_WAIT_L
#undef PG8_BAR
#undef PG8_SCHED
}
}

#define LAS __attribute__((address_space(3)))
#define CAS __attribute__((address_space(4)))
#define GAS __attribute__((address_space(1)))
typedef unsigned short bf16;
typedef float f32x4 __attribute__((ext_vector_type(4)));
typedef float f32x2 __attribute__((ext_vector_type(2)));
typedef float f32x16 __attribute__((ext_vector_type(16)));
typedef short bf16x8 __attribute__((ext_vector_type(8)));
typedef short s16x4 __attribute__((ext_vector_type(4)));
typedef unsigned u32x4 __attribute__((ext_vector_type(4)));
typedef unsigned u32x2 __attribute__((ext_vector_type(2)));
typedef __bf16 bf16x2_t __attribute__((ext_vector_type(2)));

constexpr int M = 16384, D = 2048, T = 4096, NB = 4, DFF = 5632, DPLE = 256;
constexpr int NIN0 = 6400, NZ = 3328, DH = 1024;
constexpr int NTHREADS = 512, NWAVES = 8;
constexpr float RMS_EPS = 1e-6f;
constexpr int SEGT = 512, NSEG = T / SEGT;
constexpr int REC = 512;

constexpr size_t SZ_WGU = (size_t)2 * DFF * D * 2, SZ_WD = (size_t)D * DFF * 2, SZ_WPG = (size_t)D * D * 2, SZ_WPP = (size_t)D * DPLE * 2;
constexpr size_t OFF_WGU1 = 0;
constexpr size_t OFF_WD1 = OFF_WGU1 + 2 * SZ_WGU;
constexpr size_t OFF_WGU2 = OFF_WD1 + 2 * SZ_WD;
constexpr size_t OFF_WD2 = OFF_WGU2 + 2 * SZ_WGU;
constexpr size_t OFF_WPG = OFF_WD2 + 2 * SZ_WD;
constexpr size_t OFF_WPP = OFF_WPG + 2 * SZ_WPG;
constexpr size_t OFF_WIN0 = OFF_WPP + 2 * SZ_WPP;
constexpr size_t OFF_WOUT0 = OFF_WIN0 + (size_t)NIN0 * D * 2;
constexpr size_t OFF_WSIN = OFF_WOUT0 + (size_t)D * D * 2;
constexpr size_t OFF_WSOUT = OFF_WSIN + (size_t)DH * D * 2;
constexpr size_t OFF_HB = OFF_WSOUT + (size_t)2 * D * DH * 2;
constexpr size_t OFF_PB = OFF_HB + (size_t)M * D * 2;
constexpr size_t OFF_SS = OFF_PB + (size_t)2 * M * DPLE * 2;
constexpr size_t OFF_R = OFF_SS + (size_t)8 * M * 4;
constexpr size_t OFF_QB = OFF_R, OFF_KB = OFF_QB + (size_t)M * DH * 2, OFF_VT = OFF_KB + (size_t)M * DH * 2, OFF_Z = OFF_VT + (size_t)M * DH * 2;
constexpr size_t OFF_U = OFF_R, OFF_YS = OFF_U + (size_t)M * DH * 2;
constexpr size_t SZ_R = (size_t)3 * M * DH * 2 + (size_t)M * NZ * 2;
static_assert(SZ_R >= (size_t)M * DFF * 2, "ACT fits the aliased region");
constexpr size_t OFF_MIX = OFF_R + SZ_R;
constexpr size_t OFF_SCAN = OFF_MIX + (size_t)M * D * 2;
constexpr size_t SZ_SCANSEG = (size_t)NB * 16 * SEGT * 384 * 4;
constexpr size_t OFF_BAR = OFF_SCAN + 2 * SZ_SCANSEG;
constexpr size_t BAR_BYTES = 16384;
constexpr size_t WS_END = OFF_BAR + BAR_BYTES;
static_assert(WS_END <= (size_t)840 * 1000 * 1000, "workspace budget"); static_assert(2 * SZ_SCANSEG >= (size_t)M * D * 2, "HB2 fits the scan buffers");

constexpr int LDS_BYTES = 147456;

struct Params { const float* in[40]; float* out; unsigned char* ws; };
__device__ __forceinline__ const float* inp(int i) { int k = i; asm volatile("" : "+s"(k)); return (const float*)(const GAS float*)(((const float* const CAS*)__builtin_amdgcn_kernarg_segment_ptr())[k]); }

__device__ __forceinline__ unsigned cvtpk(float lo, float hi) { f32x2 v = {lo, hi}; bf16x2_t b = __builtin_convertvector(v, bf16x2_t); return __builtin_bit_cast(unsigned, b); }
__device__ __forceinline__ float bf2f(unsigned short b) { return __builtin_bit_cast(float, (unsigned)b << 16); }
__device__ __forceinline__ float bflo(unsigned u) { return __builtin_bit_cast(float, u << 16); }
__device__ __forceinline__ float bfhi(unsigned u) { return __builtin_bit_cast(float, u & 0xffff0000u); }
__device__ __forceinline__ float wave_sum(float v) {
#pragma unroll
    for (int o = 1; o < 64; o <<= 1) v += __shfl_xor(v, o);
    return v;
}
__device__ __forceinline__ float fast_sigmoid(float x) { return __builtin_amdgcn_rcpf(1.0f + __expf(-x)); }

struct ConvJob { const float* W; const float* gain; bf16* WT; int K, nblk, ldw, mode, off; };
__device__ __forceinline__ void conv_item(const float* W, const float* gain, bf16* WT, int K, int nblk, int ldw, int mode, int off, LAS float* scr, int item, int lane) {
    const int kb = item / nblk, nb = item % nblk, k0 = 64 * kb, n0 = 32 * nb;
    float wv_[32];
#pragma unroll
    for (int i = 0; i < 32; ++i) wv_[i] = W[(size_t)(k0 + 2 * i + (lane >> 5)) * ldw + n0 + (lane & 31)];
    if (gain) {
#pragma unroll
        for (int i = 0; i < 32; ++i) wv_[i] *= gain[k0 + 2 * i + (lane >> 5)];
    }
#pragma unroll
    for (int i = 0; i < 32; ++i) scr[(2 * i + (lane >> 5)) * 33 + (lane & 31)] = wv_[i];
    asm volatile("s_waitcnt lgkmcnt(0)" ::: "memory");
    const int c = lane & 7;
    const int drow0 = mode ? ((n0 >> 7) * 256 + (n0 & 127) + off) : (n0 + off);
#pragma unroll
    for (int j = 0; j < 4; ++j) { const int n = (lane >> 3) + 8 * j; const LAS float* s = scr + (8 * c) * 33 + n;
        u32x4 o; o.x = cvtpk(s[0 * 33], s[1 * 33]); o.y = cvtpk(s[2 * 33], s[3 * 33]); o.z = cvtpk(s[4 * 33], s[5 * 33]); o.w = cvtpk(s[6 * 33], s[7 * 33]);
        *(u32x4*)(WT + (size_t)(drow0 + n) * K + k0 + 8 * c) = o; }
    asm volatile("s_waitcnt lgkmcnt(0)" ::: "memory");
}
constexpr int I_GU = (D / 64) * (DFF / 32), I_DN = (DFF / 64) * (D / 32), I_PG = (D / 64) * (D / 32), I_PP = (DPLE / 64) * (D / 32);
constexpr int I_LAYER = 4 * I_GU + 2 * I_DN + I_PG + I_PP;
constexpr int I_IN0 = (D / 64) * (NIN0 / 32), I_OUT0 = I_PG, I_SIN = (D / 64) * (DH / 32), I_SOUT = (DH / 64) * (D / 32);
constexpr int I_TOTAL = 2 * I_LAYER + I_IN0 + I_OUT0 + I_SIN + 2 * I_SOUT;

__device__ __forceinline__ void p0_prologue(unsigned char* ws, LAS unsigned char* lds, int gw, int NGW, int wave, int lane) {
    LAS float* scr = (LAS float*)(lds + wave * 16384);
    for (int it0 = gw; it0 < I_TOTAL; it0 += NGW) {
        int it = it0;
        const float* W; const float* gain = nullptr; bf16* WT; int K, N, ldw, mode = 0, off = 0;
        if (it < 2 * I_LAYER) {
            const int l = it >= I_LAYER; it -= l * I_LAYER;
            const size_t wo = (size_t)l * D * DFF;
            if (it < 2 * I_GU) { const int up = it >= I_GU; it -= up * I_GU; W = (up ? inp(4) : inp(3)) + wo; gain = inp(2) + l * D; WT = (bf16*)(ws + OFF_WGU1 + l * SZ_WGU); K = D; N = DFF; ldw = DFF; mode = 1; off = up * 128; }
            else if (it < 2 * I_GU + I_DN) { it -= 2 * I_GU; W = inp(5) + wo; WT = (bf16*)(ws + OFF_WD1 + l * SZ_WD); K = DFF; N = D; ldw = D; }
            else if (it < 4 * I_GU + I_DN) { it -= 2 * I_GU + I_DN; const int up = it >= I_GU; it -= up * I_GU; W = (up ? inp(9) : inp(8)) + wo; gain = inp(7) + l * D; WT = (bf16*)(ws + OFF_WGU2 + l * SZ_WGU); K = D; N = DFF; ldw = DFF; mode = 1; off = up * 128; }
            else if (it < 4 * I_GU + 2 * I_DN) { it -= 4 * I_GU + I_DN; W = inp(10) + wo; WT = (bf16*)(ws + OFF_WD2 + l * SZ_WD); K = DFF; N = D; ldw = D; }
            else if (it < 4 * I_GU + 2 * I_DN + I_PG) { it -= 4 * I_GU + 2 * I_DN; W = inp(12) + (size_t)l * D * D; gain = inp(11) + l * D; WT = (bf16*)(ws + OFF_WPG + l * SZ_WPG); K = D; N = D; ldw = D; }
            else { it -= 4 * I_GU + 2 * I_DN + I_PG; W = inp(13) + (size_t)l * DPLE * D; WT = (bf16*)(ws + OFF_WPP + l * SZ_WPP); K = DPLE; N = D; ldw = D; }
        } else {
            it -= 2 * I_LAYER;
            if (it < I_IN0) { W = inp(14); gain = inp(6); WT = (bf16*)(ws + OFF_WIN0); K = D; N = NIN0; ldw = NIN0; }
            else if (it < I_IN0 + I_OUT0) { it -= I_IN0; W = inp(29); WT = (bf16*)(ws + OFF_WOUT0); K = D; N = D; ldw = D; }
            else if (it < I_IN0 + I_OUT0 + I_SIN) { it -= I_IN0 + I_OUT0; W = inp(30); gain = inp(6) + D; WT = (bf16*)(ws + OFF_WSIN); K = D; N = DH; ldw = DH; }
            else { it -= I_IN0 + I_OUT0 + I_SIN; const int gt = it >= I_SOUT; it -= gt * I_SOUT; W = inp(39) + gt * D; WT = (bf16*)(ws + OFF_WSOUT); K = DH; N = D; ldw = 2 * D; mode = 1; off = gt * 128; }
        }
        conv_item(W, gain, WT, K, N / 32, ldw, mode, off, scr, it, lane);
    }
    bf16* hb = (bf16*)(ws + OFF_HB); float* ss = (float*)(ws + OFF_SS); bf16* pb = (bf16*)(ws + OFF_PB);
    const float* x = inp(0); const float* p = inp(1);
    for (int m = gw; m < M; m += NGW) {
        const f32x4* xr = (const f32x4*)(x + (size_t)m * D) + lane; float s = 0.f;
        u32x2* o = (u32x2*)(hb + (size_t)m * D) + lane;
#pragma unroll
        for (int j = 0; j < 8; ++j) { const f32x4 v = xr[64 * j]; s += (v.x * v.x + v.y * v.y) + (v.z * v.z + v.w * v.w); u32x2 w; w.x = cvtpk(v.x, v.y); w.y = cvtpk(v.z, v.w); o[64 * j] = w; }
        s = wave_sum(s);
        if (lane < 8) ss[(size_t)lane * M + m] = (lane == 0) ? s : 0.f;
    }
    for (int m = gw; m < 2 * M; m += NGW) {
        const f32x4 v = ((const f32x4*)(p + (size_t)m * DPLE))[lane]; u32x2 w; w.x = cvtpk(v.x, v.y); w.y = cvtpk(v.z, v.w);
        ((u32x2*)(pb + (size_t)m * DPLE))[lane] = w;
    }
}

using pg8::Unit;
struct EpiSwiGLU {
    static constexpr bool PERM = true, AFTER_DRAIN = false;
    bf16* ACT; const float* ss;
    __device__ __forceinline__ void operator()(const f32x4 (&acc)[2][2][4][2], const Unit& u, int wr, int wc, int fr, int fq) const {
        const int row0 = u.pm * 256 + wr * 64 + fr, col0 = u.pn * 128 + wc * 32 + 8 * fq;
#pragma unroll
        for (int ai = 0; ai < 2; ++ai)
#pragma unroll
            for (int m = 0; m < 4; ++m) {
                const int row = row0 + ai * 128 + m * 16;
                const float r = __builtin_amdgcn_rsqf(ss[row] * (1.0f / D) + RMS_EPS);
                float o[8];
#pragma unroll
                for (int n = 0; n < 2; ++n)
#pragma unroll
                    for (int j = 0; j < 4; ++j) { const float g = acc[ai][0][m][n][j] * r, uu = acc[ai][1][m][n][j] * r; o[4 * n + j] = g * fast_sigmoid(g) * uu; }
                u32x4 w; w.x = cvtpk(o[0], o[1]); w.y = cvtpk(o[2], o[3]); w.z = cvtpk(o[4], o[5]); w.w = cvtpk(o[6], o[7]);
                *(u32x4*)(ACT + (size_t)row * DFF + col0) = w;
            }
    }
};
template <int MODE> struct EpiRes {
    static constexpr bool PERM = true, AFTER_DRAIN = false;
    const float* hin; float* hout; bf16* hb; float* ssn; float scale; const float* ssc; const bf16* pp;
    __device__ __forceinline__ void operator()(const f32x4 (&acc)[2][2][4][2], const Unit& u, int wr, int wc, int fr, int fq) const {
        const int row0 = u.pm * 256 + wr * 64 + fr;
#pragma unroll
        for (int ai = 0; ai < 2; ++ai)
#pragma unroll
            for (int m = 0; m < 4; ++m) {
                const int row = row0 + ai * 128 + m * 16;
                float r = 1.f; if (MODE == 2) r = __builtin_amdgcn_rsqf(ssc[row] * (1.0f / D) + RMS_EPS);
                float sq = 0.f;
#pragma unroll
                for (int bj = 0; bj < (MODE == 1 ? 1 : 2); ++bj) {
                    const int col = (MODE == 1) ? (u.pn * 128 + wc * 32 + 8 * fq) : (u.pn * 256 + bj * 128 + wc * 32 + 8 * fq);
                    const size_t idx = (size_t)row * D + col;
                    f32x4 h0 = *(const f32x4*)(hin + idx), h1 = *(const f32x4*)(hin + idx + 4);
                    f32x4 v0, v1;
                    if (MODE == 0) { v0 = acc[ai][bj][m][0] * scale; v1 = acc[ai][bj][m][1] * scale; }
                    else if (MODE == 1) {
#pragma unroll
                        for (int j = 0; j < 4; ++j) { v0[j] = acc[ai][0][m][0][j] * fast_sigmoid(acc[ai][1][m][0][j]); v1[j] = acc[ai][0][m][1][j] * fast_sigmoid(acc[ai][1][m][1][j]); }
                    } else {
                        const u32x4 pw = *(const u32x4*)(pp + idx);
                        const float pv[8] = {bflo(pw.x), bfhi(pw.x), bflo(pw.y), bfhi(pw.y), bflo(pw.z), bfhi(pw.z), bflo(pw.w), bfhi(pw.w)};
#pragma unroll
                        for (int j = 0; j < 4; ++j) { v0[j] = fast_sigmoid(acc[ai][bj][m][0][j] * r) * pv[j]; v1[j] = fast_sigmoid(acc[ai][bj][m][1][j] * r) * pv[4 + j]; }
                    }
                    h0 += v0; h1 += v1;
                    *(f32x4*)(hout + idx) = h0; *(f32x4*)(hout + idx + 4) = h1;
                    u32x4 w; w.x = cvtpk(h0[0], h0[1]); w.y = cvtpk(h0[2], h0[3]); w.z = cvtpk(h1[0], h1[1]); w.w = cvtpk(h1[2], h1[3]);
                    if (hb) *(u32x4*)(hb + idx) = w;
                    sq += (h0[0] * h0[0] + h0[1] * h0[1]) + (h0[2] * h0[2] + h0[3] * h0[3]) + (h1[0] * h1[0] + h1[1] * h1[1]) + (h1[2] * h1[2] + h1[3] * h1[3]);
                }
                sq += __shfl_xor(sq, 16); sq += __shfl_xor(sq, 32);
                if (fq == 0 && ssn) atomicAdd(ssn + row, sq);
            }
    }
};
template <bool LAYER0> struct EpiStore {
    static constexpr bool PERM = true, AFTER_DRAIN = false;
    const float* ss; bf16* O; int ldo; bf16 *QB, *KB, *VT, *Z;
    __device__ __forceinline__ void operator()(const f32x4 (&acc)[2][2][4][2], const Unit& u, int wr, int wc, int fr, int fq) const {
        const int row0 = u.pm * 256 + wr * 64 + fr;
#pragma unroll
        for (int ai = 0; ai < 2; ++ai)
#pragma unroll
            for (int m = 0; m < 4; ++m) {
                const int row = row0 + ai * 128 + m * 16;
                const float r = ss ? __builtin_amdgcn_rsqf(ss[row] * (1.0f / D) + RMS_EPS) : 1.f;
#pragma unroll
                for (int bj = 0; bj < 2; ++bj) {
                    const f32x4 v0 = acc[ai][bj][m][0] * r, v1 = acc[ai][bj][m][1] * r;
                    const int cl = bj * 128 + wc * 32 + 8 * fq;
                    if (LAYER0 && u.pn >= 8 && u.pn < 12) {
                        const int b = row >> 12, t = row & 4095, ch = (u.pn - 8) * 256 + cl;
                        bf16* vp = VT + ((size_t)(b * DH + ch)) * T + t;
                        const unsigned p0 = cvtpk(v0[0], v0[1]), p1 = cvtpk(v0[2], v0[3]), p2 = cvtpk(v1[0], v1[1]), p3 = cvtpk(v1[2], v1[3]);
                        vp[0 * (size_t)T] = (bf16)(p0 & 0xffff); vp[1 * (size_t)T] = (bf16)(p0 >> 16); vp[2 * (size_t)T] = (bf16)(p1 & 0xffff); vp[3 * (size_t)T] = (bf16)(p1 >> 16);
                        vp[4 * (size_t)T] = (bf16)(p2 & 0xffff); vp[5 * (size_t)T] = (bf16)(p2 >> 16); vp[6 * (size_t)T] = (bf16)(p3 & 0xffff); vp[7 * (size_t)T] = (bf16)(p3 >> 16);
                    } else {
                        bf16* dst;
                        if (LAYER0) {
                            if (u.pn < 4) dst = QB + (size_t)row * DH + u.pn * 256 + cl;
                            else if (u.pn < 8) dst = KB + (size_t)row * DH + (u.pn - 4) * 256 + cl;
                            else dst = Z + (size_t)row * NZ + (u.pn - 12) * 256 + cl;
                        } else dst = O + (size_t)row * ldo + u.pn * 256 + cl;
                        u32x4 w; w.x = cvtpk(v0[0], v0[1]); w.y = cvtpk(v0[2], v0[3]); w.z = cvtpk(v1[0], v1[1]); w.w = cvtpk(v1[2], v1[3]);
                        *(u32x4*)dst = w;
                    }
                }
            }
    }
};
__device__ __forceinline__ int opq(int v) { asm volatile("" : "+s"(v)); return v; }
__device__ __forceinline__ int opqv(int v) { asm volatile("" : "+v"(v)); return v; }
__device__ __forceinline__ unsigned char* wsp(unsigned char* ws, size_t off) { asm volatile("" : "+s"(ws)); return (unsigned char*)((GAS unsigned char*)ws + off); }
#define GEMM_PHASE(EPI, Aptr, Bptr, NN, KK, Eobj) do { pg8::Gemm g_{(const pg8::bf16_t*)(Aptr), (const pg8::bf16_t*)(Bptr), M, (NN), (KK)}; pg8::StaticOrder S_; S_.init(M, (NN), opq((int)gridDim.x), opq((int)blockIdx.x)); \
        pg8::gemm_phase<EPI, pg8::StaticOrder, true, true>(lds, g_, S_, (Eobj)); } while (0)

#define XB_TMO      128
#define XB_XCNT(j)  (256  + 64 * (j))
#define XB_XSUB(j)  (1280 + 64 * (j))
#define XB_XGEN(j)  (2304 + 64 * (j))
#define XB_TOP      3328
#define XB_TOPGEN   3392
#define XCD_BAR_WORDS 3456
#define XB_SPIN_CAP (1u << 18)

__device__ __forceinline__ unsigned xb_ld(unsigned* p)              { return __hip_atomic_load(p, __ATOMIC_RELAXED, __HIP_MEMORY_SCOPE_AGENT); }
__device__ __forceinline__ unsigned xb_add(unsigned* p, unsigned v) { return __hip_atomic_fetch_add(p, v, __ATOMIC_RELAXED, __HIP_MEMORY_SCOPE_AGENT); }
__device__ __forceinline__ unsigned xb_xcc_id() { return (unsigned)__builtin_amdgcn_s_getreg((3 << 11) | 20) & 0xFu; }
#define XB_SPIN(cond, bar) do { unsigned _sp = 0; while (cond) { __builtin_amdgcn_s_sleep(1); \
    if ((++_sp & 255u) == 0u) { if (xb_ld(&(bar)[XB_TMO])) break; if (_sp > XB_SPIN_CAP) { atomicAdd(&(bar)[XB_TMO], 1u); break; } } } } while (0)

struct XcdBarrier {
    unsigned* bar; unsigned x;
    volatile LAS unsigned* st;
};

__device__ __forceinline__ XcdBarrier xcd_barrier_post(unsigned* bar, volatile LAS unsigned* st) {
    XcdBarrier b; b.bar = bar; b.x = xb_xcc_id(); b.st = st;
    if (threadIdx.x == 0) (void)xb_add(&bar[XB_XCNT(b.x)], 1u);
    return b;
}
__device__ __forceinline__ void xcd_barrier_complete(unsigned* bar, unsigned x, unsigned& nloc, unsigned& nx) {
    const unsigned G = gridDim.x * gridDim.y * gridDim.z;
    unsigned sum, cnt, mine, sp = 0u;
    for (;;) {
        sum = 0u; cnt = 0u; mine = 0u;
#pragma unroll
        for (unsigned j = 0; j < 16; ++j) { const unsigned c = xb_ld(&bar[XB_XCNT(j)]); sum += c; cnt += (c > 0u) ? 1u : 0u; mine = (j == x) ? c : mine; }
        if (sum == G) break;
        __builtin_amdgcn_s_sleep(1);
        if ((++sp & 255u) == 0u) { if (xb_ld(&bar[XB_TMO])) break; if (sp > XB_SPIN_CAP) { atomicAdd(&bar[XB_TMO], 1u); break; } }
    }
    nloc = mine > 0u ? mine : 1u; nx = cnt > 0u ? cnt : 1u;
}

__device__ __forceinline__ void xcd_barrier(const XcdBarrier& b) {
    asm volatile("s_waitcnt vmcnt(0)" ::: "memory");
    __syncthreads();
    if (threadIdx.x == 0) {
        unsigned* bar = b.bar;
        __builtin_amdgcn_s_waitcnt(0);
        unsigned nloc = b.st[0], nx = b.st[1];
        if (nloc == 0u) { xcd_barrier_complete(bar, b.x, nloc, nx); b.st[0] = nloc; b.st[1] = nx; }
        const unsigned old = xb_add(&bar[XB_XSUB(b.x)], 1u);
        const unsigned gen = old / nloc;
        if (old + 1u == (gen + 1u) * nloc) {
            __builtin_amdgcn_fence(__ATOMIC_RELEASE, "agent");
            asm volatile("s_waitcnt vmcnt(0)" ::: "memory");
            const unsigned og = xb_add(&bar[XB_TOP], 1u);
            const unsigned tg = og / nx;
            if (og + 1u == (tg + 1u) * nx) xb_add(&bar[XB_TOPGEN], 1u);
            else XB_SPIN(xb_ld(&bar[XB_TOPGEN]) == tg, bar);
            __builtin_amdgcn_fence(__ATOMIC_ACQUIRE, "agent");
            xb_add(&bar[XB_XGEN(b.x)], 1u);
            asm volatile("s_waitcnt vmcnt(0)" ::: "memory");
        } else {
            XB_SPIN(xb_ld(&bar[XB_XGEN(b.x)]) == gen, bar);
            __builtin_amdgcn_fence(__ATOMIC_ACQUIRE, "agent");
            asm volatile("s_waitcnt vmcnt(0)" ::: "memory");
        }
    }
    __syncthreads();
}


constexpr size_t OFF_YRAW = OFF_QB;
constexpr size_t OFF_GG = OFF_VT;
constexpr size_t OFF_BV = OFF_HB;
constexpr int RECF = 384;
static_assert((size_t)NB * 16 * SEGT * RECF * 4 <= SZ_SCANSEG, "segment buffers fit");

__device__ __forceinline__ float quad_sum(float v) {
    v += __builtin_bit_cast(float, __builtin_amdgcn_mov_dpp(__builtin_bit_cast(int, v), 0xB1, 0xF, 0xF, true));
    v += __builtin_bit_cast(float, __builtin_amdgcn_mov_dpp(__builtin_bit_cast(int, v), 0x4E, 0xF, 0xF, true));
    return v;
}
__device__ __forceinline__ void unpack8(const u32x4 w, float* x) { x[0] = bflo(w.x); x[1] = bfhi(w.x); x[2] = bflo(w.y); x[3] = bfhi(w.y); x[4] = bflo(w.z); x[5] = bfhi(w.z); x[6] = bflo(w.w); x[7] = bfhi(w.w); }

__device__ __forceinline__ void qknorm_rows(bf16* QBp, bf16* KBp, int gw, int NGW, int lane) {
    const float* qg = inp(15); const float* kg = inp(16);
    const int d0 = (lane & 3) * 16;
    float gq[16], gk[16];
#pragma unroll
    for (int i = 0; i < 16; ++i) { gq[i] = qg[d0 + i] * 0.125f; gk[i] = kg[d0 + i]; }
    for (int it = gw; it < 2 * M; it += NGW) {
        const bool isk = it >= M; const int row = isk ? it - M : it;
        bf16* p = (isk ? KBp : QBp) + (size_t)row * DH + lane * 16;
        float x[16]; unpack8(*(const u32x4*)p, x); unpack8(*(const u32x4*)(p + 8), x + 8);
        float s = 0.f;
#pragma unroll
        for (int i = 0; i < 16; ++i) s += x[i] * x[i];
        s = quad_sum(s);
        const float rs = __builtin_amdgcn_rsqf(s * (1.0f / 64.0f) + RMS_EPS);
#pragma unroll
        for (int i = 0; i < 16; ++i) x[i] = x[i] * rs * (isk ? gk[i] : gq[i]);
        u32x4 a, b2; a.x = cvtpk(x[0], x[1]); a.y = cvtpk(x[2], x[3]); a.z = cvtpk(x[4], x[5]); a.w = cvtpk(x[6], x[7]);
        b2.x = cvtpk(x[8], x[9]); b2.y = cvtpk(x[10], x[11]); b2.z = cvtpk(x[12], x[13]); b2.w = cvtpk(x[14], x[15]);
        *(u32x4*)p = a; *(u32x4*)(p + 8) = b2;
    }
}

#define MFMA32(a, b, c) __builtin_amdgcn_mfma_f32_32x32x16_bf16((a), (b), (c), 0, 0, 0)
__device__ __forceinline__ int crow(int i, int hh) { return (i & 3) + 8 * (i >> 2) + 4 * hh; }
__device__ __forceinline__ void attn_unit(const bf16* QBp, const bf16* KBp, const bf16* VTp, bf16* MIXp, const float* biasg, int unit, int lane) {
    const int h = unit & 15, c = (unit >> 4) & 63, b = unit >> 10;
    const int r = lane & 31, hh = lane >> 5;
    const float* bias = biasg + h * 192;
    const size_t rowq0 = (size_t)b * T + c * 64;
    bf16x8 qf[2][4];
#pragma unroll
    for (int qt = 0; qt < 2; ++qt)
#pragma unroll
        for (int s = 0; s < 4; ++s) qf[qt][s] = *(const bf16x8*)(QBp + (rowq0 + 32 * qt + r) * DH + h * 64 + 16 * s + 8 * hh);
    f32x16 oacc[2][2];
#pragma unroll
    for (int a = 0; a < 2; ++a)
#pragma unroll
        for (int q = 0; q < 2; ++q)
#pragma unroll
            for (int i = 0; i < 16; ++i) oacc[a][q][i] = 0.f;
    float mrun[2] = {-1e30f, -1e30f}, lrun[2] = {0.f, 0.f};
    const float bconst = bias[191];
    for (int kc = (c < 8 ? 8 - c : 0); kc <= 8; ++kc) {
        const int kch = c - 8 + kc;
        for (int kt = 0; kt < 2; ++kt) {
            const size_t krow = (size_t)b * T + kch * 64 + kt * 32 + r;
            bf16x8 kf[4];
#pragma unroll
            for (int s = 0; s < 4; ++s) kf[s] = *(const bf16x8*)(KBp + krow * DH + h * 64 + 16 * s + 8 * hh);
            bf16x8 vf[2][2];
#pragma unroll
            for (int dt = 0; dt < 2; ++dt)
#pragma unroll
                for (int s2 = 0; s2 < 2; ++s2) {
                    const bf16* vp = VTp + ((size_t)(b * DH + h * 64 + 32 * dt + r)) * T + kch * 64 + kt * 32 + 16 * s2 + 4 * hh;
                    const s16x4 lo = *(const s16x4*)vp, hi = *(const s16x4*)(vp + 8);
                    vf[dt][s2] = (bf16x8){lo[0], lo[1], lo[2], lo[3], hi[0], hi[1], hi[2], hi[3]};
                }
#pragma unroll
            for (int qt = 0; qt < 2; ++qt) {
                f32x16 st;
#pragma unroll
                for (int i = 0; i < 16; ++i) st[i] = 0.f;
#pragma unroll
                for (int s = 0; s < 4; ++s) st = MFMA32(kf[s], qf[qt][s], st);
                if (kc <= 5) {
#pragma unroll
                    for (int i = 0; i < 16; ++i) st[i] += bconst;
                } else {
#pragma unroll
                    for (int i = 0; i < 16; ++i) { int dist = (32 * qt + r) - (kt * 32 + crow(i, hh)) + 64 * (8 - kc); dist = dist < -63 ? -63 : (dist > 128 ? 128 : dist); st[i] += bias[dist + 63]; }
                }
                float mx = st[0];
#pragma unroll
                for (int i = 1; i < 16; ++i) mx = fmaxf(mx, st[i]);
                mx = fmaxf(mx, __shfl_xor(mx, 32));
                const float mnew = fmaxf(mrun[qt], mx), alpha = __expf(mrun[qt] - mnew);
                float ls = 0.f;
#pragma unroll
                for (int i = 0; i < 16; ++i) { st[i] = __expf(st[i] - mnew); ls += st[i]; }
                ls += __shfl_xor(ls, 32);
                lrun[qt] = lrun[qt] * alpha + ls; mrun[qt] = mnew;
#pragma unroll
                for (int dt = 0; dt < 2; ++dt)
#pragma unroll
                    for (int i = 0; i < 16; ++i) oacc[dt][qt][i] *= alpha;
                bf16x8 pk[2];
#pragma unroll
                for (int s2 = 0; s2 < 2; ++s2) { u32x4 w; w.x = cvtpk(st[8 * s2], st[8 * s2 + 1]); w.y = cvtpk(st[8 * s2 + 2], st[8 * s2 + 3]); w.z = cvtpk(st[8 * s2 + 4], st[8 * s2 + 5]); w.w = cvtpk(st[8 * s2 + 6], st[8 * s2 + 7]); pk[s2] = __builtin_bit_cast(bf16x8, w); }
#pragma unroll
                for (int dt = 0; dt < 2; ++dt)
#pragma unroll
                    for (int s2 = 0; s2 < 2; ++s2) oacc[dt][qt] = MFMA32(vf[dt][s2], pk[s2], oacc[dt][qt]);
            }
        }
    }
#pragma unroll
    for (int qt = 0; qt < 2; ++qt) {
        const float inv = 1.0f / lrun[qt];
        bf16* orow = MIXp + (rowq0 + 32 * qt + r) * D + h * 64;
#pragma unroll
        for (int dt = 0; dt < 2; ++dt)
#pragma unroll
            for (int g4 = 0; g4 < 4; ++g4) { u32x2 w; w.x = cvtpk(oacc[dt][qt][4 * g4] * inv, oacc[dt][qt][4 * g4 + 1] * inv); w.y = cvtpk(oacc[dt][qt][4 * g4 + 2] * inv, oacc[dt][qt][4 * g4 + 3] * inv);
                *(u32x2*)(orow + 32 * dt + 8 * g4 + 4 * hh) = w; }
    }
}

__device__ __forceinline__ f32x2 row16_sum2(f32x2 v) {
    float x = v.x, y = v.y;
#define DPPADD(r, ctl) "v_add_f32_dpp " r ", " r ", " r " " ctl " row_mask:0xf bank_mask:0xf bound_ctrl:1\n\t"
    asm volatile("s_nop 1\n\t"
                 DPPADD("%0", "quad_perm:[1,0,3,2]") DPPADD("%1", "quad_perm:[1,0,3,2]") "s_nop 0\n\t"
                 DPPADD("%0", "quad_perm:[2,3,0,1]") DPPADD("%1", "quad_perm:[2,3,0,1]") "s_nop 0\n\t"
                 DPPADD("%0", "row_ror:4") DPPADD("%1", "row_ror:4") "s_nop 0\n\t"
                 DPPADD("%0", "row_ror:8") DPPADD("%1", "row_ror:8")
                 : "+v"(x), "+v"(y));
#undef DPPADD
    return (f32x2){x, y};
}
constexpr int PREP_TB = 16;
constexpr int XB_STRIDE = 528, XB_BYTES = 16 * XB_STRIDE;
constexpr int WL_OFF = 4 * XB_BYTES;
constexpr int RING_OFF = WL_OFF + 32768;
__device__ __forceinline__ void load_lora_lds(LAS unsigned char* lds, int head, int tid) {
    const float* wup = inp(20); const float* aup = inp(22); const float* gup = inp(23);
    for (int e = tid; e < 64 * 32; e += NTHREADS) {
        const int kc = e >> 6, ch = e & 63, c = head * 64 + ch, k0 = 8 * kc;
        const float* src = (k0 < 64) ? (wup + (size_t)k0 * DH) : (k0 < 128) ? (aup + (size_t)(k0 - 64) * DH) : (gup + (size_t)(k0 - 128) * DH);
        float w[8];
#pragma unroll
        for (int i = 0; i < 8; ++i) w[i] = src[(size_t)i * DH + c];
        u32x4 o; o.x = cvtpk(w[0], w[1]); o.y = cvtpk(w[2], w[3]); o.z = cvtpk(w[4], w[5]); o.w = cvtpk(w[6], w[7]);
        *(LAS u32x4*)(lds + WL_OFF + ch * 512 + ((kc ^ (ch & 15)) * 16)) = o;
    }
}
__device__ __forceinline__ void prep_wave_item(const bf16* Zp, float* SEGp, bf16* GGp, bf16* BVp, LAS unsigned char* XB  , const LAS unsigned char* WLT, int seg, int b, int head, int tb, int lane) {
    const int t0 = seg * SEGT + tb * PREP_TB;
    const float* mu = inp(18);
#pragma unroll 2
    for (int it = 0; it < 8; ++it) {
        const int idx = it * 64 + lane, tk = idx >> 5, col8 = (idx & 31) * 8, t = t0 + tk; const size_t row = (size_t)b * T + t;
        float z[8], zp[8];
        unpack8(*(const u32x4*)(Zp + row * NZ + 3072 + col8), z);
        if (t > 0) unpack8(*(const u32x4*)(Zp + (row - 1) * NZ + 3072 + col8), zp); else {
#pragma unroll
            for (int e = 0; e < 8; ++e) zp[e] = 0.f; }
        const f32x4 m0 = *(const f32x4*)(mu + 3072 + col8), m1 = *(const f32x4*)(mu + 3072 + col8 + 4);
        float x[8];
#pragma unroll
        for (int e = 0; e < 8; ++e) { float v = z[e] + (zp[e] - z[e]) * (e < 4 ? m0[e] : m1[e - 4]);
            if (col8 < 64) v = 1.f - 2.f * __builtin_amdgcn_rcpf(__expf(2.f * v) + 1.f); else if (col8 >= 128) v = fast_sigmoid(v);
            x[e] = v; }
        u32x4 o; o.x = cvtpk(x[0], x[1]); o.y = cvtpk(x[2], x[3]); o.z = cvtpk(x[4], x[5]); o.w = cvtpk(x[6], x[7]);
        *(LAS u32x4*)(XB + tk * XB_STRIDE + col8 * 2) = o;
    }
    const int fr = lane & 15, fq = lane >> 4;
    pg8::f32x4 accw[4], acca[4], accg[4];
#pragma unroll
    for (int n = 0; n < 4; ++n) { accw[n] = (pg8::f32x4){0.f, 0.f, 0.f, 0.f}; acca[n] = accw[n]; accg[n] = accw[n]; }
#define LORA_MFMA(acc_, koff_, nks_) _Pragma("unroll") for (int s = 0; s < (nks_); ++s) { \
        const bf16x8 af = *(const LAS bf16x8*)(XB + fr * XB_STRIDE + ((koff_) + 32 * s + 8 * fq) * 2); \
        _Pragma("unroll") for (int n = 0; n < 4; ++n) { const int chn = 16 * n + fr, chunk = ((koff_) >> 3) + 4 * s + fq; \
            const bf16x8 bfr = *(const LAS bf16x8*)(WLT + chn * 512 + ((chunk ^ fr) * 16)); acc_[n] = __builtin_amdgcn_mfma_f32_16x16x32_bf16(af, bfr, acc_[n], 0, 0, 0); } }
    LORA_MFMA(accw, 0, 2)
    LORA_MFMA(acca, 64, 2)
    LORA_MFMA(accg, 128, 4)
#undef LORA_MFMA
    const int tq = t0 + 4 * fq;
    float kkv[4][4], kpv[4][4], rrv[4][4], vvv[4][4], av[4][4], dec[4][4], rkc[4];
#pragma unroll
    for (int n = 0; n < 4; ++n) {
        const int c = head * 64 + 16 * n + fr;
        const float mur = mu[c], muk = mu[DH + c], muv = mu[2 * DH + c];
        const float w0c = inp(19)[c], a0c = inp(21)[c], kkc = inp(24)[c], kac = inp(25)[c]; rkc[n] = inp(26)[c];
        float zr_p = 0.f, zk_p = 0.f, zv_p = 0.f;
        if (tq > 0) { const size_t rowp = (size_t)b * T + tq - 1; zr_p = bf2f(Zp[rowp * NZ + c]); zk_p = bf2f(Zp[rowp * NZ + DH + c]); zv_p = bf2f(Zp[rowp * NZ + 2 * DH + c]); }
#pragma unroll
        for (int j = 0; j < 4; ++j) {
            const size_t row = (size_t)b * T + tq + j;
            const float zr = bf2f(Zp[row * NZ + c]), zk = bf2f(Zp[row * NZ + DH + c]), zv = bf2f(Zp[row * NZ + 2 * DH + c]);
            const float rr = zr + (zr_p - zr) * mur, kk0 = zk + (zk_p - zk) * muk, vv = zv + (zv_p - zv) * muv;
            zr_p = zr; zk_p = zk; zv_p = zv;
            const float wl = -(w0c + accw[n][j]);
            const float sp = fmaxf(wl, 0.f) + __logf(1.f + __expf(-fabsf(wl)));
            dec[n][j] = __expf(-__expf(-sp - 0.5f));
            const float a = fast_sigmoid(a0c + acca[n][j]);
            av[n][j] = a; kkv[n][j] = kk0 * kkc; kpv[n][j] = kk0 * (1.f + (a - 1.f) * kac); rrv[n][j] = rr; vvv[n][j] = vv;
        }
    }
#pragma unroll
    for (int j = 0; j < 4; ++j) {
        float n2 = 0.f, bo = 0.f;
#pragma unroll
        for (int n = 0; n < 4; ++n) { n2 += kkv[n][j] * kkv[n][j]; bo += rrv[n][j] * kpv[n][j] * rkc[n]; }
        const f32x2 red = row16_sum2((f32x2){n2, bo});
        const float inv = 1.0f / fmaxf(sqrtf(red.x), 1e-12f), bonus = red.y;
        const int t = tq + j; const size_t row = (size_t)b * T + t;
        float* rec = SEGp + ((size_t)((((seg & 1) * NB + b) * 16 + head) * SEGT + (t - seg * SEGT))) * RECF;
#pragma unroll
        for (int n = 0; n < 4; ++n) {
            const int i = 16 * n + fr, c = head * 64 + i; const float kk = kkv[n][j] * inv;
            rec[i] = -kk; rec[64 + i] = dec[n][j]; rec[128 + i] = kk * av[n][j]; rec[192 + i] = kpv[n][j]; rec[256 + i] = rrv[n][j]; rec[320 + i] = vvv[n][j];
            GGp[row * DH + c] = (bf16)(cvtpk(accg[n][j], 0.f) & 0xffff); BVp[row * DH + c] = (bf16)(cvtpk(bonus * vvv[n][j], 0.f) & 0xffff);
        }
    }
}

__device__ __forceinline__ float dot4(const f32x4 a, const f32x4 b) { return (a[0] * b[0] + a[1] * b[1]) + (a[2] * b[2] + a[3] * b[3]); }
__device__ __forceinline__ float row16_sum(float v) {
    v += __builtin_bit_cast(float, __builtin_amdgcn_mov_dpp(__builtin_bit_cast(int, v), 0xB1, 0xF, 0xF, true));
    v += __builtin_bit_cast(float, __builtin_amdgcn_mov_dpp(__builtin_bit_cast(int, v), 0x4E, 0xF, 0xF, true));
    v += __builtin_bit_cast(float, __builtin_amdgcn_mov_dpp(__builtin_bit_cast(int, v), 0x124, 0xF, 0xF, true));
    v += __builtin_bit_cast(float, __builtin_amdgcn_mov_dpp(__builtin_bit_cast(int, v), 0x128, 0xF, 0xF, true));
    return v;
}
template <bool HOT = false> __device__ __forceinline__ void scan_segment(const float* SEGp, float* Yp, LAS unsigned char* lds, int seg, int hidx, int rg, int wv, int lane, f32x4& S) {
    __builtin_amdgcn_s_setprio(3);
    const int kg = lane & 15, rw = lane >> 4;
    const int b = hidx >> 4, h = hidx & 15;
    constexpr int BS = 4, NBATCH = SEGT / BS;
    LAS float* RING = (LAS float*)(lds + RING_OFF) + wv * (2 * BS * 384);
    const float* recs = SEGp + ((size_t)((((seg & 1) * NB + b) * 16 + h) * SEGT)) * RECF;
    const int vrow = rg * 16 + wv * 4;
    float* yout = Yp + ((size_t)b * T + seg * SEGT) * DH + h * 64 + vrow + rw;
    const int k0 = kg * 4;
#pragma unroll
    for (int j = 0; j < BS; ++j) { const float* rp = recs + (size_t)j * RECF;
        *(LAS f32x4*)(RING + j * 384 + 4 * lane) = *(const f32x4*)(rp + 4 * lane);
        *(LAS f32x4*)(RING + j * 384 + 256 + 4 * (lane & 31)) = *(const f32x4*)(rp + 256 + 4 * (lane & 31)); }
#define LOADOPS(dst, dvv, slot_) do { const LAS float* o_ = RING + (slot_) * 384; \
        _Pragma("unroll") for (int q_ = 0; q_ < 5; ++q_) dst[q_] = *(const LAS f32x4*)(o_ + k0 + q_ * 64); dvv = o_[320 + vrow + rw]; } while (0)
    f32x4 cur[5]; float cvv;
    LOADOPS(cur, cvv, 0);
    float sa = row16_sum(dot4(S, cur[0]));
    for (int B = 0; B < NBATCH; ++B) {
        f32x4 pfa[BS], pfb[BS];
        const bool more = (B + 1 < NBATCH);
        if (more) {
#pragma unroll
            for (int j = 0; j < BS; ++j) { const float* rp = recs + (size_t)(BS * (HOT ? (B & 1) : (B + 1)) + j) * RECF;
                pfa[j] = *(const f32x4*)(rp + 4 * lane); pfb[j] = *(const f32x4*)(rp + 256 + 4 * (lane & 31)); }
        }
        float ys[BS];
#pragma unroll
        for (int j = 0; j < BS; ++j) {
            const int slot = (B & 1) * BS + j;
            if (j == BS - 1 && more) {
#pragma unroll
                for (int jj = 0; jj < BS; ++jj) { LAS float* d = RING + (((B + 1) & 1) * BS + jj) * 384;
                    *(LAS f32x4*)(d + 4 * lane) = pfa[jj]; *(LAS f32x4*)(d + 256 + 4 * (lane & 31)) = pfb[jj]; }
            }
            f32x4 nxt[5]; float nvv = 0.f;
            if (j < BS - 1) LOADOPS(nxt, nvv, slot + 1);
            else if (more) LOADOPS(nxt, nvv, ((B + 1) & 1) * BS);
            else {
#pragma unroll
                for (int q = 0; q < 5; ++q) nxt[q] = cur[q]; }
            S = (S * cur[1] + cvv * cur[3]) + sa * cur[2];
            f32x2 pr = {dot4(S, cur[4]), dot4(S, nxt[0])};
            pr = row16_sum2(pr);
            ys[j] = pr.x; sa = pr.y;
#pragma unroll
            for (int q = 0; q < 5; ++q) cur[q] = nxt[q];
            cvv = nvv;
        }
        if (kg == 0) {
#pragma unroll
            for (int j = 0; j < BS; ++j) yout[(size_t)(BS * B + j) * DH] = ys[j]; }
    }
#undef LOADOPS
    __builtin_amdgcn_s_setprio(0);
}

__device__ __forceinline__ float half_sum(float v) {
#pragma unroll
    for (int o = 1; o < 32; o <<= 1) v += __shfl_xor(v, o);
    return v;
}
__device__ __forceinline__ void rwkv_post(const float* Yp, const bf16* GGp, const bf16* BVp, bf16* MIXp, int gw, int NGW, int lane) {
    const float* lw = inp(27); const float* lb = inp(28);
    const int hsel = lane >> 5, cp = lane & 31;
    for (int it = gw; it < M * 8; it += NGW) {
        const int row = it >> 3, c = (2 * (it & 7) + hsel) * 64 + 2 * cp;
        const f32x2 y = *(const f32x2*)(Yp + (size_t)row * DH + c);
        const float mean = half_sum(y.x + y.y) * (1.0f / 64.0f), d0 = y.x - mean, d1 = y.y - mean;
        const float var = half_sum(d0 * d0 + d1 * d1) * (1.0f / 64.0f);
        const float rs = __builtin_amdgcn_rsqf(var + 64e-5f);
        const unsigned bv = *(const unsigned*)(BVp + (size_t)row * DH + c), gg = *(const unsigned*)(GGp + (size_t)row * DH + c);
        const f32x2 w2 = *(const f32x2*)(lw + c), b2 = *(const f32x2*)(lb + c);
        const float o0 = (d0 * rs * w2.x + b2.x + bflo(bv)) * bflo(gg), o1 = (d1 * rs * w2.y + b2.y + bfhi(bv)) * bfhi(gg);
        *(unsigned*)(MIXp + (size_t)row * D + DH + c) = cvtpk(o0, o1);
    }
}

__device__ __forceinline__ float gelu_tanh(float x) {
    const float t = 0.7978845608028654f * (x + 0.044715f * x * x * x);
    const float e = __expf(2.f * t);
    const float th = 1.f - 2.f * __builtin_amdgcn_rcpf(e + 1.f);
    return 0.5f * x * (1.f + th);
}
__device__ __forceinline__ void s5_unit(const bf16* U, bf16* YS, LAS unsigned char* lds, int b, int g, int tid) {
    constexpr int CT = 128;
    const int lane = tid & 63, wv = tid >> 6, fr = lane & 15, fq = lane >> 4;
    const int pw = wv & 3, half = wv >> 2, p = 16 * pw + fr, seg = 4 * half + fq;
    LAS bf16* usb0 = (LAS bf16*)lds;
    LAS float* E = (LAS float*)(lds + 2 * CT * 32);
    LAS float* CAR = E + 8 * 64 * 2;
    LAS bf16* Hb0 = (LAS bf16*)(CAR + 128);
    const float* bre_p = inp(34); const float* bim_p = inp(35); const float* cre_p = inp(36); const float* cim_p = inp(37); const float* dsk_p = inp(38);
    const float lr = inp(31)[g * 64 + p], li = inp(32)[g * 64 + p], dt = expf(inp(33)[g]);
    const float mag = expf(lr * dt), are = mag * cosf(li * dt), aim = mag * sinf(li * dt);
    const float den = lr * lr + li * li;
    const float zre = ((are - 1.f) * lr + aim * li) / den, zim = (aim * lr - (are - 1.f) * li) / den;
    bf16x8 bfr_re, bfr_im;
    {
        float wr[8], wi[8];
#pragma unroll
        for (int i = 0; i < 8; ++i) { const int c = 8 * (fq & 1) + i; const float br = bre_p[(g * 64 + p) * 16 + c], bi = bim_p[(g * 64 + p) * 16 + c];
            wr[i] = (fq < 2) ? (zre * br - zim * bi) : 0.f; wi[i] = (fq < 2) ? (zre * bi + zim * br) : 0.f; }
        u32x4 a, c2; a.x = cvtpk(wr[0], wr[1]); a.y = cvtpk(wr[2], wr[3]); a.z = cvtpk(wr[4], wr[5]); a.w = cvtpk(wr[6], wr[7]);
        c2.x = cvtpk(wi[0], wi[1]); c2.y = cvtpk(wi[2], wi[3]); c2.z = cvtpk(wi[4], wi[5]); c2.w = cvtpk(wi[6], wi[7]);
        bfr_re = __builtin_bit_cast(bf16x8, a); bfr_im = __builtin_bit_cast(bf16x8, c2);
    }
    float pwr[16], pwi[16];
    pwr[0] = are; pwi[0] = aim;
#pragma unroll
    for (int q = 1; q < 16; ++q) { pwr[q] = pwr[q - 1] * are - pwi[q - 1] * aim; pwi[q] = pwr[q - 1] * aim + pwi[q - 1] * are; }
    bf16x8 cfrag[4];
#pragma unroll
    for (int s = 0; s < 4; ++s) { const int kk0 = 32 * s + 8 * fq; const float* src = (kk0 < 64) ? (cre_p + g * 1024 + fr * 64 + kk0) : (cim_p + g * 1024 + fr * 64 + (kk0 - 64)); const float sg = (kk0 < 64) ? 1.f : -1.f;
        const f32x4 c0v = *(const f32x4*)src, c1v = *(const f32x4*)(src + 4); u32x4 w; w.x = cvtpk(sg * c0v[0], sg * c0v[1]); w.y = cvtpk(sg * c0v[2], sg * c0v[3]); w.z = cvtpk(sg * c1v[0], sg * c1v[1]); w.w = cvtpk(sg * c1v[2], sg * c1v[3]);
        cfrag[s] = __builtin_bit_cast(bf16x8, w); }
    const float dch = dsk_p[g * 16 + fr];
    if (tid < 64) { CAR[2 * tid] = 0.f; CAR[2 * tid + 1] = 0.f; }
    u32x4 unext = {0u, 0u, 0u, 0u};
    if (tid < 2 * CT) unext = *(const u32x4*)(U + (size_t)(b * T + (tid >> 1)) * DH + g * 16 + (tid & 1) * 8);
    __syncthreads();
    for (int ch = 0; ch < T / CT; ++ch) {
        const int row0 = b * T + ch * CT;
        LAS bf16* usb = usb0 + (ch & 1) * (CT * 16); LAS bf16* Hb = Hb0 + (ch & 1) * (CT * 136);
        if (tid < 2 * CT) {
            const int t = tid >> 1, hf = tid & 1;
            *(LAS u32x4*)(usb + t * 16 + hf * 8) = unext;
            if (ch + 1 < T / CT) unext = *(const u32x4*)(U + (size_t)(row0 + CT + t) * DH + g * 16 + hf * 8);
        }
        __syncthreads();
        float hr[16], hi[16]; float sr = 0.f, si = 0.f;
#pragma unroll
        for (int m = 0; m < 4; ++m) {
            const int tokA = 64 * half + 16 * (fr >> 2) + 4 * m + (fr & 3);
            bf16x8 af = {0, 0, 0, 0, 0, 0, 0, 0};
            if (fq < 2) af = *(const LAS bf16x8*)(usb + tokA * 16 + 8 * fq);
            const pg8::f32x4 z4 = {0.f, 0.f, 0.f, 0.f};
            const pg8::f32x4 ar = __builtin_amdgcn_mfma_f32_16x16x32_bf16(af, bfr_re, z4, 0, 0, 0);
            const pg8::f32x4 ai = __builtin_amdgcn_mfma_f32_16x16x32_bf16(af, bfr_im, z4, 0, 0, 0);
#pragma unroll
            for (int j = 0; j < 4; ++j) { const float nr = are * sr - aim * si + ar[j], ni = are * si + aim * sr + ai[j]; sr = nr; si = ni; hr[4 * m + j] = sr; hi[4 * m + j] = si; }
        }
        E[(seg * 64 + p) * 2] = sr; E[(seg * 64 + p) * 2 + 1] = si;
        __syncthreads();
        float cr = CAR[2 * p], ci = CAR[2 * p + 1];
        for (int s = 0; s < seg; ++s) { const float er = E[(s * 64 + p) * 2], ei = E[(s * 64 + p) * 2 + 1];
            const float nr = pwr[15] * cr - pwi[15] * ci + er, ni = pwr[15] * ci + pwi[15] * cr + ei; cr = nr; ci = ni; }
#pragma unroll
        for (int q = 0; q < 16; ++q) {
            const float fr_ = hr[q] + pwr[q] * cr - pwi[q] * ci, fi_ = hi[q] + pwr[q] * ci + pwi[q] * cr;
            { const unsigned pkd = cvtpk(fr_, fi_); Hb[(seg * 16 + q) * 136 + p] = (bf16)(pkd & 0xffff); Hb[(seg * 16 + q) * 136 + 64 + p] = (bf16)(pkd >> 16); }
            if (q == 15) { hr[15] = fr_; hi[15] = fi_; }
        }
        __syncthreads();
        if (seg == 7) { CAR[2 * p] = hr[15]; CAR[2 * p + 1] = hi[15]; }
        {
            pg8::f32x4 acc = {0.f, 0.f, 0.f, 0.f};
#pragma unroll
            for (int s = 0; s < 4; ++s) { const bf16x8 a = *(const LAS bf16x8*)(Hb + (wv * 16 + fr) * 136 + 32 * s + 8 * fq); acc = __builtin_amdgcn_mfma_f32_16x16x32_bf16(a, cfrag[s], acc, 0, 0, 0); }
            float yv[4];
#pragma unroll
            for (int j = 0; j < 4; ++j) { const int t = wv * 16 + 4 * fq + j; yv[j] = gelu_tanh(acc[j] + dch * bf2f(usb[t * 16 + fr])); }
            const bool odd = (fr & 1) != 0;
#pragma unroll
            for (int jp = 0; jp < 2; ++jp) {
                const float mine = odd ? yv[2 * jp + 1] : yv[2 * jp], send = odd ? yv[2 * jp] : yv[2 * jp + 1];
                const float recv = __builtin_bit_cast(float, __builtin_amdgcn_mov_dpp(__builtin_bit_cast(int, send), 0xB1, 0xF, 0xF, true));
                const int t = wv * 16 + 4 * fq + 2 * jp + (odd ? 1 : 0);
                *(unsigned*)(YS + (size_t)(row0 + t) * DH + g * 16 + (fr & ~1)) = odd ? cvtpk(recv, mine) : cvtpk(mine, recv);
            }
        }
    }
    __syncthreads();
}

__global__ void __launch_bounds__(NTHREADS, 2) fwd_megakernel(Params P) {
    extern __shared__ __attribute__((aligned(16))) unsigned char lds_raw[];
    cg::grid_group grid = cg::this_grid();
    LAS unsigned char* lds = (LAS unsigned char*)lds_raw;
    const int tid = threadIdx.x, lane = tid & 63, wave = __builtin_amdgcn_readfirstlane(tid >> 6);
    const int G = gridDim.x, bid = blockIdx.x;
    const int gw = bid * NWAVES + wave, NGW = G * NWAVES;
    unsigned char* ws = P.ws;
#define OUTP ((float*)(GAS float*)P.out)
#ifndef REP_SYNC
#define REP_SYNC 0
#endif
#ifndef REP_SCAN
#define REP_SCAN 1
#endif
#ifndef REP_PREP
#define REP_PREP 1
#endif
#ifndef REP_P0
#define REP_P0 1
#endif
#ifndef REP_GU
#define REP_GU 1
#endif
#ifndef REP_RWKV
#define REP_RWKV 1
#endif
#ifndef REP_ATT
#define REP_ATT 1
#endif
#ifndef REP_S5
#define REP_S5 1
#endif
#ifndef REP_INPROJ
#define REP_INPROJ 1
#endif
    { volatile LAS unsigned* st0 = (volatile LAS unsigned*)(lds + 131072 + 64); if (threadIdx.x < 2) st0[threadIdx.x] = 0u; __syncthreads(); }
    const XcdBarrier xbar = xcd_barrier_post((unsigned*)(GAS unsigned*)(ws + OFF_BAR), (volatile LAS unsigned*)(lds + 131072 + 64));
#define GSYNC() xcd_barrier(xbar)
#define TICK(k) do { } while (0)
#define HB ((bf16*)wsp(ws, OFF_HB))
#define HB2 ((bf16*)wsp(ws, OFF_SCAN))
#define PB ((bf16*)wsp(ws, OFF_PB))
#define SSP(j) ((float*)wsp(ws, OFF_SS + (size_t)(j) * M * 4))
#define ACT ((bf16*)wsp(ws, OFF_R))
#define MIX ((bf16*)wsp(ws, OFF_MIX))
#define QB ((bf16*)wsp(ws, OFF_QB))
#define KB ((bf16*)wsp(ws, OFF_KB))
#define VT ((bf16*)wsp(ws, OFF_VT))
#define ZB ((bf16*)wsp(ws, OFF_Z))
#define UB ((bf16*)wsp(ws, OFF_U))
#define YS ((bf16*)wsp(ws, OFF_YS))
    for (int rep = 0; rep < REP_P0; ++rep) { if (rep) grid.sync(); const int t_ = opqv((int)threadIdx.x), wv_ = __builtin_amdgcn_readfirstlane(t_ >> 6); p0_prologue(ws, lds, opq((int)blockIdx.x) * NWAVES + wv_, opq((int)gridDim.x) * NWAVES, wv_, t_ & 63); }
    if (P.ws == nullptr) grid.sync();
    GSYNC(); TICK(0);

    for (int rs_ = 0; rs_ < REP_SYNC; ++rs_) GSYNC();
    for (int l = 0; l < 2; ++l) {
        const float* hin0 = (l == 0) ? inp(0) : OUTP;
        for (int rep = 0; rep < ((l == 0) ? REP_GU : 1); ++rep) { if (rep) GSYNC(); EpiSwiGLU E{ACT, SSP(4 * l)}; GEMM_PHASE(EpiSwiGLU, (l == 0) ? HB : HB2, wsp(ws, OFF_WGU1) + l * SZ_WGU, 2 * DFF, D, E); }
        GSYNC(); TICK(1);
        { EpiRes<0> E{hin0, OUTP, HB, SSP(4 * l + 1), 0.5f, nullptr, nullptr}; GEMM_PHASE(EpiRes<0>, ACT, wsp(ws, OFF_WD1) + l * SZ_WD, D, DFF, E); }
        GSYNC(); TICK(2);
        if (l == 0) {
            for (int rep = 0; rep < REP_INPROJ; ++rep) { if (rep) GSYNC(); EpiStore<true> E{SSP(4 * l + 1), nullptr, 0, QB, KB, VT, ZB}; GEMM_PHASE(EpiStore<true>, HB, wsp(ws, OFF_WIN0), NIN0, D, E); }
            GSYNC(); TICK(3);
            #define HMAP const int x_ = bid_ & 7, y_ = bid_ >> 3, rg_ = y_ & 3, hidx_ = (y_ >> 2) * 8 + x_;
            #define OPQ_IDS const int t_ = opqv((int)threadIdx.x), ln_ = t_ & 63, bid_ = opq((int)blockIdx.x), G_ = opq((int)gridDim.x), gw_ = bid_ * NWAVES + __builtin_amdgcn_readfirstlane(t_ >> 6), NGW_ = G_ * NWAVES; (void)ln_; (void)gw_; (void)NGW_;
            { OPQ_IDS qknorm_rows(QB, KB, gw_, NGW_, ln_); }
            GSYNC(); TICK(4);
            for (int rep = 0; rep < REP_ATT; ++rep) { if (rep) GSYNC(); OPQ_IDS const float* biasg = inp(17);
#pragma unroll 1
            for (int k2_ = 0; ; ++k2_) { const int v_ = 2 * gw_ + (k2_ & 1) + (k2_ >> 1) * 2 * NGW_; if (v_ >= NB * 64 * 16) break; const int bh_ = v_ >> 6, c_ = v_ & 63;
                attn_unit(QB, KB, VT, MIX, biasg, (((bh_ >> 4) * 64 + c_) << 4) | (bh_ & 15), ln_); } }
            GSYNC(); TICK(4);
            { OPQ_IDS HMAP load_lora_lds(lds, hidx_ & 15, t_); __syncthreads(); }
            for (int rep = 0; rep < REP_RWKV; ++rep) { f32x4 Sst = {0.f, 0.f, 0.f, 0.f};
              for (int s = 0; s <= NSEG; ++s) {
                if (REP_SCAN > 1 && s >= 1) { OPQ_IDS HMAP f32x4 Sd = Sst; if ((t_ >> 6) < 4) scan_segment<(REP_SCAN > 2)>((const float*)wsp(ws, OFF_SCAN), (float*)wsp(ws, OFF_YRAW), lds, s - 1, hidx_, rg_, __builtin_amdgcn_readfirstlane(t_ >> 6), ln_, Sd); }
                if (s >= 1) { OPQ_IDS HMAP if ((t_ >> 6) < 4) scan_segment((const float*)wsp(ws, OFF_SCAN), (float*)wsp(ws, OFF_YRAW), lds, s - 1, hidx_, rg_, __builtin_amdgcn_readfirstlane(t_ >> 6), ln_, Sst); }
                if (s < NSEG) for (int rp_ = 0; rp_ < REP_PREP; ++rp_) { OPQ_IDS HMAP const int wv_ = __builtin_amdgcn_readfirstlane(t_ >> 6), pw_ = wv_ - 4;
                  if (s == 0) { for (int tb_ = rg_ * 8 + wv_; tb_ < SEGT / PREP_TB; tb_ += 32)
                      prep_wave_item(ZB, (float*)wsp(ws, OFF_SCAN), (bf16*)wsp(ws, OFF_GG), (bf16*)wsp(ws, OFF_BV), (wv_ < 4) ? (lds + RING_OFF + wv_ * XB_BYTES) : (lds + pw_ * XB_BYTES), lds + WL_OFF, s, hidx_ >> 4, hidx_ & 15, tb_, ln_); }
                  else if (pw_ >= 0) for (int tb_ = rg_ * 4 + pw_; tb_ < SEGT / PREP_TB; tb_ += 16) prep_wave_item(ZB, (float*)wsp(ws, OFF_SCAN), (bf16*)wsp(ws, OFF_GG), (bf16*)wsp(ws, OFF_BV), lds + pw_ * XB_BYTES, lds + WL_OFF, s, hidx_ >> 4, hidx_ & 15, tb_, ln_); }
                GSYNC(); TICK(5);
              } }
            { OPQ_IDS rwkv_post((const float*)wsp(ws, OFF_YRAW), (const bf16*)wsp(ws, OFF_GG), (const bf16*)wsp(ws, OFF_BV), MIX, gw_, NGW_, ln_); }
            GSYNC(); TICK(5);
            { EpiRes<0> E{OUTP, OUTP, HB, SSP(4 * l + 2), 1.0f, nullptr, nullptr}; GEMM_PHASE(EpiRes<0>, MIX, wsp(ws, OFF_WOUT0), D, D, E); }
            GSYNC(); TICK(7);
        } else {
            { EpiStore<false> E{SSP(4 * l + 1), UB, DH, nullptr, nullptr, nullptr, nullptr}; GEMM_PHASE(EpiStore<false>, HB, wsp(ws, OFF_WSIN), DH, D, E); }
            GSYNC(); TICK(7);
            for (int rep = 0; rep < REP_S5; ++rep) { if (rep) GSYNC(); OPQ_IDS for (int un = bid_; un < NB * 64; un += G_) s5_unit(UB, YS, lds, un >> 6, un & 63, t_); } GSYNC(); TICK(6);
            { EpiRes<1> E{OUTP, OUTP, HB, SSP(4 * l + 2), 1.0f, nullptr, nullptr}; GEMM_PHASE(EpiRes<1>, YS, wsp(ws, OFF_WSOUT), 2 * D, DH, E); }
            GSYNC(); TICK(7);
        }
        { EpiSwiGLU E{ACT, SSP(4 * l + 2)}; GEMM_PHASE(EpiSwiGLU, HB, wsp(ws, OFF_WGU2) + l * SZ_WGU, 2 * DFF, D, E); }
        GSYNC(); TICK(1);
        { EpiRes<0> E{OUTP, OUTP, HB, SSP(4 * l + 3), 0.5f, nullptr, nullptr}; GEMM_PHASE(EpiRes<0>, ACT, wsp(ws, OFF_WD2) + l * SZ_WD, D, DFF, E); }
        { EpiStore<false> E{nullptr, MIX, D, nullptr, nullptr, nullptr, nullptr}; GEMM_PHASE(EpiStore<false>, PB + (size_t)l * M * DPLE, wsp(ws, OFF_WPP) + l * SZ_WPP, D, DPLE, E); }
        GSYNC(); TICK(2);
        { EpiRes<2> E{OUTP, OUTP, (l == 0) ? HB2 : (bf16*)nullptr  , (l == 0) ? (SSP(4 * l + 4)) : nullptr, 1.0f, SSP(4 * l + 3), MIX}; GEMM_PHASE(EpiRes<2>, HB, wsp(ws, OFF_WPG) + l * SZ_WPG, D, D, E); }
        if (l == 0) GSYNC(); TICK(7);
    }
}

extern "C" void kernel_launch(void* const* d_in, const int* in_sizes, int n_in, void* d_out, int out_size, void* d_ws, size_t ws_size, hipStream_t stream) {
    static int grid_blocks = 0;
    if (grid_blocks == 0) {
        int dev = 0, cus = 0, per_cu = 0;
        hipGetDevice(&dev); hipDeviceGetAttribute(&cus, hipDeviceAttributeMultiprocessorCount, dev);
        hipFuncSetAttribute((const void*)fwd_megakernel, hipFuncAttributeMaxDynamicSharedMemorySize, LDS_BYTES);
        hipOccupancyMaxActiveBlocksPerMultiprocessor(&per_cu, (const void*)fwd_megakernel, NTHREADS, LDS_BYTES);
        if (per_cu < 1) { fprintf(stderr, "occupancy query returned %d\n", per_cu); per_cu = 1; }
        grid_blocks = cus * per_cu;
        if (ws_size < WS_END) fprintf(stderr, "workspace too small: %zu < %zu\n", ws_size, (size_t)WS_END);
    }
    (void)hipMemsetAsync((unsigned char*)d_ws + OFF_BAR, 0, BAR_BYTES, stream);
    Params p{};
    unsigned char* ws = (unsigned char*)d_ws;
    for (int i = 0; i < 40; ++i) p.in[i] = (const float*)d_in[i];
    p.out = (float*)d_out; p.ws = ws;

    void* args[] = {&p};
    hipError_t e = hipLaunchCooperativeKernel((const void*)fwd_megakernel, dim3(grid_blocks), dim3(NTHREADS), args, LDS_BYTES, stream);
    if (e != hipSuccess) fprintf(stderr, "cooperative launch failed: %s (grid %d)\n", hipGetErrorString(e), grid_blocks);
}
```

```cpp
#include <hip/hip_runtime.h>
#include <hip/hip_cooperative_groups.h>
#include <cstdio>
#include <cstdint>
namespace cg = cooperative_groups;
namespace pg8 {
#define PG8_LAS __attribute__((address_space(3)))
typedef unsigned short bf16_t;
typedef short bf16x8 __attribute__((ext_vector_type(8)));
typedef float f32x4 __attribute__((ext_vector_type(4)));
typedef unsigned u32x4 __attribute__((ext_vector_type(4)));
constexpr int BM = 256, BK = 64, HALF = 128, HTB = HALF * BK * 2  , STAGE_BYTES = 8 * HTB, NXCD = 8, WGM = 4;

__host__ __device__ __forceinline__ int lds_byte(int r, int c) { const int st = (r >> 4) * 2 + (c >> 5), rr = r & 15, cc = c & 31, ob = rr * 64 + cc * 2; return st * 1024 + (ob ^ (((ob >> 9) & 1) << 5)); }
__host__ __device__ __forceinline__ void stage_rc(int b, int& R, int& C) { const int st = b / 1024, sb = b % 1024, swz = sb ^ (((sb >> 9) & 1) << 5); R = (st >> 1) * 16 + swz / 64; C = (st & 1) * 32 + (swz % 64) / 2; }
__host__ __device__ __forceinline__ int perm32(int rho) { const int n = rho >> 4, i = rho & 15; return 8 * (i >> 2) + 4 * n + (i & 3); }

struct Unit { int pm, pn; };
struct Gemm { const bf16_t* A; const bf16_t* Bt; int M, N, K; };

struct StaticOrder {
    int nM, nN, nwg, G, c;
    __host__ __device__ void init(int M, int N, int G_, int c_) { nM = M / BM; nN = N / BM; nwg = nM * nN; G = G_; c = c_; }
    __host__ __device__ bool next(int i, Unit& u) const {
        const long L = (long)i * G + c; if (L >= nwg) return false;
        int wgid = (int)L; { const int q = nwg / NXCD, r = nwg % NXCD, xcd = wgid % NXCD, off = wgid / NXCD; wgid = (xcd < r ? xcd * (q + 1) : r * (q + 1) + (xcd - r) * q) + off; }
        const int nig = WGM * nN, gid = wgid / nig, fm = gid * WGM, gsz = (nM - fm) < WGM ? (nM - fm) : WGM;
        u.pm = fm + ((wgid % nig) % gsz); u.pn = (wgid % nig) / gsz; return true;
    }
    __device__ __forceinline__ void a_ready(const Unit&) const {}
    __device__ __forceinline__ void done(const Unit&) const {}
};

__device__ __forceinline__ unsigned cvt_pk_bf16(float lo, float hi) { unsigned r; asm volatile("v_cvt_pk_bf16_f32 %0, %1, %2" : "=v"(r) : "v"(lo), "v"(hi)); return r; }
template <class Epi, class Sched, bool ALIGN_EPI = false, bool SP2 = false>
__device__ __forceinline__ void gemm_phase(PG8_LAS unsigned char* lds, const Gemm g, const Sched& S, const Epi& E) {
    int tid_o = threadIdx.x; asm volatile("" : "+v"(tid_o));
    const int tid = tid_o, wid = __builtin_amdgcn_readfirstlane(tid >> 6), lane = tid & 63, wr = wid >> 2, wc = wid & 3, fr = lane & 15, fq = lane >> 4;
    const int K = g.K, nt = K / BK;
    unsigned voffA[2], voffB[2];
#pragma unroll
    for (int i = 0; i < 2; ++i) { int R, C; stage_rc(tid * 16 + i * 8192, R, C); const int Rb = Epi::PERM ? ((R & ~31) + perm32(R & 31)) : R;
        voffA[i] = (unsigned)(R * K + C) * 2u; voffB[i] = (unsigned)(Rb * K + C) * 2u; }
    const size_t kstep = (size_t)(BK * 2);
    const size_t hstep = (size_t)HALF * K * 2;
    const size_t tstep = 2 * hstep;
    const unsigned ldsw = (unsigned)wid * 1024u;
    const int aoff = lds_byte(wr * 64 + fr, fq * 8), boff = lds_byte(wc * 32 + fr, fq * 8);
#define PG8_SA(b, h) (((b) * 2 + (h)) * HTB)
#define PG8_SB(b, h) ((4 + (b) * 2 + (h)) * HTB)
#define PG8_STAGE(bufoff, gbase, voff) do { _Pragma("unroll") for (int _i = 0; _i < 2; ++_i) \
        __builtin_amdgcn_global_load_lds((const unsigned*)((const char*)(gbase) + (voff)[_i]), (PG8_LAS unsigned*)(lds + (bufoff) + ldsw + _i * 8192), 16, 0, 0); } while (0)
#define PG8_LDA(dst, b, h) do { _Pragma("unroll") for (int m = 0; m < 4; ++m) _Pragma("unroll") for (int k = 0; k < 2; ++k) dst[m][k] = *(const PG8_LAS bf16x8*)(lds + PG8_SA(b, h) + aoff + m * 2048 + k * 1024); } while (0)
#define PG8_LDB(dst, b, h) do { _Pragma("unroll") for (int n = 0; n < 2; ++n) _Pragma("unroll") for (int k = 0; k < 2; ++k) dst[n][k] = *(const PG8_LAS bf16x8*)(lds + PG8_SB(b, h) + boff + n * 2048 + k * 1024); } while (0)
#define PG8_MMA(ai, bj, At, Bt) do { __builtin_amdgcn_s_setprio(1); _Pragma("unroll") for (int m = 0; m < 4; ++m) _Pragma("unroll") for (int n = 0; n < 2; ++n) _Pragma("unroll") for (int k = 0; k < 2; ++k) \
        acc[ai][bj][m][n] = __builtin_amdgcn_mfma_f32_16x16x32_bf16(Bt[n][k], At[m][k], acc[ai][bj][m][n], 0, 0, 0); __builtin_amdgcn_s_setprio(0); } while (0)
#define PG8_WAIT_V(n) asm volatile("s_waitcnt vmcnt(" #n ")" ::: "memory")
#define PG8_WAIT_L(n) asm volatile("s_waitcnt lgkmcnt(" #n ")" ::: "memory")
#define PG8_BAR __builtin_amdgcn_s_barrier()
#define PG8_SCHED __builtin_amdgcn_sched_barrier(0)
    Unit cur, nxt; int ui = 0;
    if (!S.next(0, cur)) return;
    f32x4 acc[2][2][4][2];
#pragma unroll
    for (int a = 0; a < 2; ++a)
#pragma unroll
        for (int b = 0; b < 2; ++b)
#pragma unroll
            for (int m = 0; m < 4; ++m)
#pragma unroll
                for (int n = 0; n < 2; ++n) acc[a][b][m][n] = (f32x4){0.f, 0.f, 0.f, 0.f};
    bf16x8 At[4][2], B0[2][2], B1[2][2];
    const char* cA = (const char*)g.A + (size_t)cur.pm * tstep; const char* cB = (const char*)g.Bt + (size_t)cur.pn * tstep;
    S.a_ready(cur);
    if constexpr (SP2) {
        PG8_STAGE(PG8_SB(0, 0), cB, voffB); PG8_STAGE(PG8_SB(0, 1), cB + hstep, voffB); PG8_STAGE(PG8_SA(0, 0), cA, voffA); PG8_STAGE(PG8_SA(0, 1), cA + hstep, voffA);
        if (wr == 1) PG8_BAR;
        PG8_WAIT_V(2); PG8_BAR;
        PG8_STAGE(PG8_SB(1, 0), cB + kstep, voffB); PG8_STAGE(PG8_SA(1, 0), cA + kstep, voffA); PG8_STAGE(PG8_SB(1, 1), cB + hstep + kstep, voffB);
        PG8_WAIT_V(6); PG8_BAR;
    } else {
        PG8_STAGE(PG8_SB(0, 0), cB, voffB); PG8_STAGE(PG8_SA(0, 0), cA, voffA); PG8_STAGE(PG8_SB(0, 1), cB + hstep, voffB); PG8_STAGE(PG8_SA(0, 1), cA + hstep, voffA);
        if (wr == 1) PG8_BAR;
        PG8_WAIT_V(4); PG8_BAR;
        PG8_STAGE(PG8_SB(1, 0), cB + kstep, voffB); PG8_STAGE(PG8_SA(1, 0), cA + kstep, voffA); PG8_STAGE(PG8_SB(1, 1), cB + hstep + kstep, voffB);
        PG8_WAIT_V(6); PG8_BAR;
    }
    for (;;) {
        const bool has_next = S.next(ui + 1, nxt);
        const char* nA = has_next ? (const char*)g.A + (size_t)nxt.pm * tstep : cA; const char* nB = has_next ? (const char*)g.Bt + (size_t)nxt.pn * tstep : cB;
        for (int t = 0; t < nt; t += 2) {
            const bool last = (t == nt - 2);
            const char* a1 = cA + (size_t)(t + 1) * kstep;
            const char* a2 = last ? nA : cA + (size_t)(t + 2) * kstep; const char* b2 = last ? nB : cB + (size_t)(t + 2) * kstep;
            const char* a3 = a2 + kstep; const char* b3 = b2 + kstep;
            if (last && has_next) S.a_ready(nxt);
            if constexpr (SP2) {
            PG8_LDB(B0, 0, 0); PG8_LDB(B1, 0, 1); PG8_SCHED; PG8_LDA(At, 0, 0); PG8_STAGE(PG8_SA(1, 1), a1 + hstep, voffA);
            PG8_WAIT_V(8); PG8_WAIT_L(0); PG8_BAR; PG8_MMA(0, 0, At, B0); PG8_MMA(0, 1, At, B1); PG8_BAR; PG8_SCHED;
            PG8_LDA(At, 0, 1); PG8_STAGE(PG8_SB(0, 0), b2, voffB); PG8_STAGE(PG8_SB(0, 1), b2 + hstep, voffB); PG8_STAGE(PG8_SA(0, 0), a2, voffA);
            PG8_WAIT_V(8); PG8_WAIT_L(0); PG8_BAR; PG8_MMA(1, 0, At, B0); PG8_MMA(1, 1, At, B1); PG8_BAR; PG8_SCHED;
            PG8_LDB(B0, 1, 0); PG8_LDB(B1, 1, 1); PG8_SCHED; PG8_LDA(At, 1, 0); PG8_STAGE(PG8_SA(0, 1), a2 + hstep, voffA);
            PG8_WAIT_V(8); PG8_WAIT_L(0); PG8_BAR; PG8_MMA(0, 0, At, B0); PG8_MMA(0, 1, At, B1); PG8_BAR; PG8_SCHED;
            PG8_LDA(At, 1, 1); PG8_STAGE(PG8_SB(1, 0), b3, voffB); PG8_STAGE(PG8_SB(1, 1), b3 + hstep, voffB); PG8_STAGE(PG8_SA(1, 0), a3, voffA);
            PG8_WAIT_V(8); PG8_WAIT_L(0); PG8_BAR; PG8_MMA(1, 0, At, B0); PG8_MMA(1, 1, At, B1); PG8_BAR; PG8_SCHED;
            } else {
            PG8_LDB(B0, 0, 0); PG8_SCHED; PG8_LDA(At, 0, 0); PG8_STAGE(PG8_SA(1, 1), a1 + hstep, voffA);
            PG8_WAIT_L(8); PG8_BAR; PG8_WAIT_L(0); PG8_MMA(0, 0, At, B0); PG8_BAR; PG8_SCHED;
            PG8_LDB(B1, 0, 1); PG8_STAGE(PG8_SB(0, 0), b2, voffB);
            PG8_BAR; PG8_WAIT_L(0); PG8_MMA(0, 1, At, B1); PG8_BAR;
            PG8_LDA(At, 0, 1); PG8_STAGE(PG8_SA(0, 0), a2, voffA);
            PG8_BAR; PG8_WAIT_L(0); PG8_MMA(1, 0, At, B0); PG8_BAR; PG8_SCHED;
            PG8_STAGE(PG8_SB(0, 1), b2 + hstep, voffB);
            PG8_WAIT_V(6); PG8_BAR; PG8_MMA(1, 1, At, B1); PG8_BAR;
            PG8_LDB(B0, 1, 0); PG8_SCHED; PG8_LDA(At, 1, 0); PG8_STAGE(PG8_SA(0, 1), a2 + hstep, voffA);
            PG8_WAIT_L(8); PG8_BAR; PG8_WAIT_L(0); PG8_MMA(0, 0, At, B0); PG8_BAR; PG8_SCHED;
            PG8_LDB(B1, 1, 1); PG8_STAGE(PG8_SB(1, 0), b3, voffB);
            PG8_BAR; PG8_WAIT_L(0); PG8_MMA(0, 1, At, B1); PG8_BAR;
            PG8_LDA(At, 1, 1); PG8_STAGE(PG8_SA(1, 0), a3, voffA);
            PG8_BAR; PG8_WAIT_L(0); PG8_MMA(1, 0, At, B0); PG8_BAR; PG8_SCHED;
            PG8_STAGE(PG8_SB(1, 1), b3 + hstep, voffB);
            PG8_WAIT_V(6); PG8_BAR; PG8_MMA(1, 1, At, B1); PG8_BAR;
            }
        }
        if constexpr (ALIGN_EPI) { if (wr == 0) PG8_BAR; }
        if constexpr (!Epi::AFTER_DRAIN) { E(acc, cur, wr, wc, fr, fq); S.done(cur); }
        if (!has_next) break;
#pragma unroll
        for (int a = 0; a < 2; ++a)
#pragma unroll
            for (int b = 0; b < 2; ++b)
#pragma unroll
                for (int m = 0; m < 4; ++m)
#pragma unroll
                    for (int n = 0; n < 2; ++n) acc[a][b][m][n] = (f32x4){0.f, 0.f, 0.f, 0.f};
        cur = nxt; cA = nA; cB = nB; ++ui;
        if constexpr (ALIGN_EPI) { if (wr == 1) PG8_BAR; }
    }
    PG8_WAIT_V(0);
    if constexpr (!ALIGN_EPI) { if (wr == 0) PG8_BAR; }
    PG8_BAR;
    if constexpr (Epi::AFTER_DRAIN) { E.fused(acc, cur, wr, wc, fr, fq, lds, wid, lane); S.done(cur); }
#undef PG8_SA
#undef PG8_SB
#undef PG8_STAGE
#undef PG8_LDA
#undef PG8_LDB
#undef PG8_MMA
#undef PG8_WAIT_V
#undef PG8_WAIT_L
#undef PG8_BAR
#undef PG8_SCHED
}
}

#define LAS __attribute__((address_space(3)))
#define CAS __attribute__((address_space(4)))
#define GAS __attribute__((address_space(1)))
typedef unsigned short bf16;
typedef float f32x4 __attribute__((ext_vector_type(4)));
typedef float f32x2 __attribute__((ext_vector_type(2)));
typedef float f32x16 __attribute__((ext_vector_type(16)));
typedef short bf16x8 __attribute__((ext_vector_type(8)));
typedef short s16x4 __attribute__((ext_vector_type(4)));
typedef unsigned u32x4 __attribute__((ext_vector_type(4)));
typedef unsigned u32x2 __attribute__((ext_vector_type(2)));
typedef __bf16 bf16x2_t __attribute__((ext_vector_type(2)));

constexpr int M = 16384, D = 2048, T = 4096, NB = 4, DFF = 5632, DPLE = 256;
constexpr int NIN0 = 6400, NZ = 3328, DH = 1024;
constexpr int NTHREADS = 512, NWAVES = 8;
constexpr float RMS_EPS = 1e-6f;
constexpr int SEGT = 512, NSEG = T / SEGT;
constexpr int REC = 512;

constexpr size_t SZ_WGU = (size_t)2 * DFF * D * 2, SZ_WD = (size_t)D * DFF * 2, SZ_WPG = (size_t)D * D * 2, SZ_WPP = (size_t)D * DPLE * 2;
constexpr size_t OFF_WGU1 = 0;
constexpr size_t OFF_WD1 = OFF_WGU1 + 2 * SZ_WGU;
constexpr size_t OFF_WGU2 = OFF_WD1 + 2 * SZ_WD;
constexpr size_t OFF_WD2 = OFF_WGU2 + 2 * SZ_WGU;
constexpr size_t OFF_WPG = OFF_WD2 + 2 * SZ_WD;
constexpr size_t OFF_WPP = OFF_WPG + 2 * SZ_WPG;
constexpr size_t OFF_WIN0 = OFF_WPP + 2 * SZ_WPP;
constexpr size_t OFF_WOUT0 = OFF_WIN0 + (size_t)NIN0 * D * 2;
constexpr size_t OFF_WSIN = OFF_WOUT0 + (size_t)D * D * 2;
constexpr size_t OFF_WSOUT = OFF_WSIN + (size_t)DH * D * 2;
constexpr size_t OFF_HB = OFF_WSOUT + (size_t)2 * D * DH * 2;
constexpr size_t OFF_PB = OFF_HB + (size_t)M * D * 2;
constexpr size_t OFF_SS = OFF_PB + (size_t)2 * M * DPLE * 2;
constexpr size_t OFF_R = OFF_SS + (size_t)8 * M * 4;
constexpr size_t OFF_QB = OFF_R, OFF_KB = OFF_QB + (size_t)M * DH * 2, OFF_VT = OFF_KB + (size_t)M * DH * 2, OFF_Z = OFF_VT + (size_t)M * DH * 2;
constexpr size_t OFF_U = OFF_R, OFF_YS = OFF_U + (size_t)M * DH * 2;
constexpr size_t SZ_R = (size_t)3 * M * DH * 2 + (size_t)M * NZ * 2;
static_assert(SZ_R >= (size_t)M * DFF * 2, "ACT fits the aliased region");
constexpr size_t OFF_MIX = OFF_R + SZ_R;
constexpr size_t OFF_SCAN = OFF_MIX + (size_t)M * D * 2;
constexpr size_t SZ_SCANSEG = (size_t)NB * 16 * SEGT * 384 * 4;
constexpr size_t OFF_BAR = OFF_SCAN + 2 * SZ_SCANSEG;
constexpr size_t BAR_BYTES = 16384;
constexpr size_t WS_END = OFF_BAR + BAR_BYTES;
static_assert(WS_END <= (size_t)840 * 1000 * 1000, "workspace budget"); static_assert(2 * SZ_SCANSEG >= (size_t)M * D * 2, "HB2 fits the scan buffers");

constexpr int LDS_BYTES = 147456;

struct Params { const float* in[40]; float* out; unsigned char* ws; };
__device__ __forceinline__ const float* inp(int i) { int k = i; asm volatile("" : "+s"(k)); return (const float*)(const GAS float*)(((const float* const CAS*)__builtin_amdgcn_kernarg_segment_ptr())[k]); }

__device__ __forceinline__ unsigned cvtpk(float lo, float hi) { f32x2 v = {lo, hi}; bf16x2_t b = __builtin_convertvector(v, bf16x2_t); return __builtin_bit_cast(unsigned, b); }
__device__ __forceinline__ float bf2f(unsigned short b) { return __builtin_bit_cast(float, (unsigned)b << 16); }
__device__ __forceinline__ float bflo(unsigned u) { return __builtin_bit_cast(float, u << 16); }
__device__ __forceinline__ float bfhi(unsigned u) { return __builtin_bit_cast(float, u & 0xffff0000u); }
__device__ __forceinline__ float wave_sum(float v) {
#pragma unroll
    for (int o = 1; o < 64; o <<= 1) v += __shfl_xor(v, o);
    return v;
}
__device__ __forceinline__ float fast_sigmoid(float x) { return __builtin_amdgcn_rcpf(1.0f + __expf(-x)); }

struct ConvJob { const float* W; const float* gain; bf16* WT; int K, nblk, ldw, mode, off; };
__device__ __forceinline__ void conv_item(const float* W, const float* gain, bf16* WT, int K, int nblk, int ldw, int mode, int off, LAS float* scr, int item, int lane) {
    const int kb = item / nblk, nb = item % nblk, k0 = 64 * kb, n0 = 32 * nb;
    float wv_[32];
#pragma unroll
    for (int i = 0; i < 32; ++i) wv_[i] = W[(size_t)(k0 + 2 * i + (lane >> 5)) * ldw + n0 + (lane & 31)];
    if (gain) {
#pragma unroll
        for (int i = 0; i < 32; ++i) wv_[i] *= gain[k0 + 2 * i + (lane >> 5)];
    }
#pragma unroll
    for (int i = 0; i < 32; ++i) scr[(2 * i + (lane >> 5)) * 33 + (lane & 31)] = wv_[i];
    asm volatile("s_waitcnt lgkmcnt(0)" ::: "memory");
    const int c = lane & 7;
    const int drow0 = mode ? ((n0 >> 7) * 256 + (n0 & 127) + off) : (n0 + off);
#pragma unroll
    for (int j = 0; j < 4; ++j) { const int n = (lane >> 3) + 8 * j; const LAS float* s = scr + (8 * c) * 33 + n;
        u32x4 o; o.x = cvtpk(s[0 * 33], s[1 * 33]); o.y = cvtpk(s[2 * 33], s[3 * 33]); o.z = cvtpk(s[4 * 33], s[5 * 33]); o.w = cvtpk(s[6 * 33], s[7 * 33]);
        *(u32x4*)(WT + (size_t)(drow0 + n) * K + k0 + 8 * c) = o; }
    asm volatile("s_waitcnt lgkmcnt(0)" ::: "memory");
}
constexpr int I_GU = (D / 64) * (DFF / 32), I_DN = (DFF / 64) * (D / 32), I_PG = (D / 64) * (D / 32), I_PP = (DPLE / 64) * (D / 32);
constexpr int I_LAYER = 4 * I_GU + 2 * I_DN + I_PG + I_PP;
constexpr int I_IN0 = (D / 64) * (NIN0 / 32), I_OUT0 = I_PG, I_SIN = (D / 64) * (DH / 32), I_SOUT = (DH / 64) * (D / 32);
constexpr int I_TOTAL = 2 * I_LAYER + I_IN0 + I_OUT0 + I_SIN + 2 * I_SOUT;

__device__ __forceinline__ void p0_prologue(unsigned char* ws, LAS unsigned char* lds, int gw, int NGW, int wave, int lane) {
    LAS float* scr = (LAS float*)(lds + wave * 16384);
    for (int it0 = gw; it0 < I_TOTAL; it0 += NGW) {
        int it = it0;
        const float* W; const float* gain = nullptr; bf16* WT; int K, N, ldw, mode = 0, off = 0;
        if (it < 2 * I_LAYER) {
            const int l = it >= I_LAYER; it -= l * I_LAYER;
            const size_t wo = (size_t)l * D * DFF;
            if (it < 2 * I_GU) { const int up = it >= I_GU; it -= up * I_GU; W = (up ? inp(4) : inp(3)) + wo; gain = inp(2) + l * D; WT = (bf16*)(ws + OFF_WGU1 + l * SZ_WGU); K = D; N = DFF; ldw = DFF; mode = 1; off = up * 128; }
            else if (it < 2 * I_GU + I_DN) { it -= 2 * I_GU; W = inp(5) + wo; WT = (bf16*)(ws + OFF_WD1 + l * SZ_WD); K = DFF; N = D; ldw = D; }
            else if (it < 4 * I_GU + I_DN) { it -= 2 * I_GU + I_DN; const int up = it >= I_GU; it -= up * I_GU; W = (up ? inp(9) : inp(8)) + wo; gain = inp(7) + l * D; WT = (bf16*)(ws + OFF_WGU2 + l * SZ_WGU); K = D; N = DFF; ldw = DFF; mode = 1; off = up * 128; }
            else if (it < 4 * I_GU + 2 * I_DN) { it -= 4 * I_GU + I_DN; W = inp(10) + wo; WT = (bf16*)(ws + OFF_WD2 + l * SZ_WD); K = DFF; N = D; ldw = D; }
            else if (it < 4 * I_GU + 2 * I_DN + I_PG) { it -= 4 * I_GU + 2 * I_DN; W = inp(12) + (size_t)l * D * D; gain = inp(11) + l * D; WT = (bf16*)(ws + OFF_WPG + l * SZ_WPG); K = D; N = D; ldw = D; }
            else { it -= 4 * I_GU + 2 * I_DN + I_PG; W = inp(13) + (size_t)l * DPLE * D; WT = (bf16*)(ws + OFF_WPP + l * SZ_WPP); K = DPLE; N = D; ldw = D; }
        } else {
            it -= 2 * I_LAYER;
            if (it < I_IN0) { W = inp(14); gain = inp(6); WT = (bf16*)(ws + OFF_WIN0); K = D; N = NIN0; ldw = NIN0; }
            else if (it < I_IN0 + I_OUT0) { it -= I_IN0; W = inp(29); WT = (bf16*)(ws + OFF_WOUT0); K = D; N = D; ldw = D; }
            else if (it < I_IN0 + I_OUT0 + I_SIN) { it -= I_IN0 + I_OUT0; W = inp(30); gain = inp(6) + D; WT = (bf16*)(ws + OFF_WSIN); K = D; N = DH; ldw = DH; }
            else { it -= I_IN0 + I_OUT0 + I_SIN; const int gt = it >= I_SOUT; it -= gt * I_SOUT; W = inp(39) + gt * D; WT = (bf16*)(ws + OFF_WSOUT); K = DH; N = D; ldw = 2 * D; mode = 1; off = gt * 128; }
        }
        conv_item(W, gain, WT, K, N / 32, ldw, mode, off, scr, it, lane);
    }
    bf16* hb = (bf16*)(ws + OFF_HB); float* ss = (float*)(ws + OFF_SS); bf16* pb = (bf16*)(ws + OFF_PB);
    const float* x = inp(0); const float* p = inp(1);
    for (int m = gw; m < M; m += NGW) {
        const f32x4* xr = (const f32x4*)(x + (size_t)m * D) + lane; float s = 0.f;
        u32x2* o = (u32x2*)(hb + (size_t)m * D) + lane;
#pragma unroll
        for (int j = 0; j < 8; ++j) { const f32x4 v = xr[64 * j]; s += (v.x * v.x + v.y * v.y) + (v.z * v.z + v.w * v.w); u32x2 w; w.x = cvtpk(v.x, v.y); w.y = cvtpk(v.z, v.w); o[64 * j] = w; }
        s = wave_sum(s);
        if (lane < 8) ss[(size_t)lane * M + m] = (lane == 0) ? s : 0.f;
    }
    for (int m = gw; m < 2 * M; m += NGW) {
        const f32x4 v = ((const f32x4*)(p + (size_t)m * DPLE))[lane]; u32x2 w; w.x = cvtpk(v.x, v.y); w.y = cvtpk(v.z, v.w);
        ((u32x2*)(pb + (size_t)m * DPLE))[lane] = w;
    }
}

using pg8::Unit;
struct EpiSwiGLU {
    static constexpr bool PERM = true, AFTER_DRAIN = false;
    bf16* ACT; const float* ss;
    __device__ __forceinline__ void operator()(const f32x4 (&acc)[2][2][4][2], const Unit& u, int wr, int wc, int fr, int fq) const {
        const int row0 = u.pm * 256 + wr * 64 + fr, col0 = u.pn * 128 + wc * 32 + 8 * fq;
#pragma unroll
        for (int ai = 0; ai < 2; ++ai)
#pragma unroll
            for (int m = 0; m < 4; ++m) {
                const int row = row0 + ai * 128 + m * 16;
                const float r = __builtin_amdgcn_rsqf(ss[row] * (1.0f / D) + RMS_EPS);
                float o[8];
#pragma unroll
                for (int n = 0; n < 2; ++n)
#pragma unroll
                    for (int j = 0; j < 4; ++j) { const float g = acc[ai][0][m][n][j] * r, uu = acc[ai][1][m][n][j] * r; o[4 * n + j] = g * fast_sigmoid(g) * uu; }
                u32x4 w; w.x = cvtpk(o[0], o[1]); w.y = cvtpk(o[2], o[3]); w.z = cvtpk(o[4], o[5]); w.w = cvtpk(o[6], o[7]);
                *(u32x4*)(ACT + (size_t)row * DFF + col0) = w;
            }
    }
};
template <int MODE> struct EpiRes {
    static constexpr bool PERM = true, AFTER_DRAIN = false;
    const float* hin; float* hout; bf16* hb; float* ssn; float scale; const float* ssc; const bf16* pp;
    __device__ __forceinline__ void operator()(const f32x4 (&acc)[2][2][4][2], const Unit& u, int wr, int wc, int fr, int fq) const {
        const int row0 = u.pm * 256 + wr * 64 + fr;
#pragma unroll
        for (int ai = 0; ai < 2; ++ai)
#pragma unroll
            for (int m = 0; m < 4; ++m) {
                const int row = row0 + ai * 128 + m * 16;
                float r = 1.f; if (MODE == 2) r = __builtin_amdgcn_rsqf(ssc[row] * (1.0f / D) + RMS_EPS);
                float sq = 0.f;
#pragma unroll
                for (int bj = 0; bj < (MODE == 1 ? 1 : 2); ++bj) {
                    const int col = (MODE == 1) ? (u.pn * 128 + wc * 32 + 8 * fq) : (u.pn * 256 + bj * 128 + wc * 32 + 8 * fq);
                    const size_t idx = (size_t)row * D + col;
                    f32x4 h0 = *(const f32x4*)(hin + idx), h1 = *(const f32x4*)(hin + idx + 4);
                    f32x4 v0, v1;
                    if (MODE == 0) { v0 = acc[ai][bj][m][0] * scale; v1 = acc[ai][bj][m][1] * scale; }
                    else if (MODE == 1) {
#pragma unroll
                        for (int j = 0; j < 4; ++j) { v0[j] = acc[ai][0][m][0][j] * fast_sigmoid(acc[ai][1][m][0][j]); v1[j] = acc[ai][0][m][1][j] * fast_sigmoid(acc[ai][1][m][1][j]); }
                    } else {
                        const u32x4 pw = *(const u32x4*)(pp + idx);
                        const float pv[8] = {bflo(pw.x), bfhi(pw.x), bflo(pw.y), bfhi(pw.y), bflo(pw.z), bfhi(pw.z), bflo(pw.w), bfhi(pw.w)};
#pragma unroll
                        for (int j = 0; j < 4; ++j) { v0[j] = fast_sigmoid(acc[ai][bj][m][0][j] * r) * pv[j]; v1[j] = fast_sigmoid(acc[ai][bj][m][1][j] * r) * pv[4 + j]; }
                    }
                    h0 += v0; h1 += v1;
                    *(f32x4*)(hout + idx) = h0; *(f32x4*)(hout + idx + 4) = h1;
                    u32x4 w; w.x = cvtpk(h0[0], h0[1]); w.y = cvtpk(h0[2], h0[3]); w.z = cvtpk(h1[0], h1[1]); w.w = cvtpk(h1[2], h1[3]);
                    if (hb) *(u32x4*)(hb + idx) = w;
                    sq += (h0[0] * h0[0] + h0[1] * h0[1]) + (h0[2] * h0[2] + h0[3] * h0[3]) + (h1[0] * h1[0] + h1[1] * h1[1]) + (h1[2] * h1[2] + h1[3] * h1[3]);
                }
                sq += __shfl_xor(sq, 16); sq += __shfl_xor(sq, 32);
                if (fq == 0 && ssn) atomicAdd(ssn + row, sq);
            }
    }
};
template <bool LAYER0> struct EpiStore {
    static constexpr bool PERM = true, AFTER_DRAIN = false;
    const float* ss; bf16* O; int ldo; bf16 *QB, *KB, *VT, *Z;
    __device__ __forceinline__ void operator()(const f32x4 (&acc)[2][2][4][2], const Unit& u, int wr, int wc, int fr, int fq) const {
        const int row0 = u.pm * 256 + wr * 64 + fr;
#pragma unroll
        for (int ai = 0; ai < 2; ++ai)
#pragma unroll
            for (int m = 0; m < 4; ++m) {
                const int row = row0 + ai * 128 + m * 16;
                const float r = ss ? __builtin_amdgcn_rsqf(ss[row] * (1.0f / D) + RMS_EPS) : 1.f;
#pragma unroll
                for (int bj = 0; bj < 2; ++bj) {
                    const f32x4 v0 = acc[ai][bj][m][0] * r, v1 = acc[ai][bj][m][1] * r;
                    const int cl = bj * 128 + wc * 32 + 8 * fq;
                    if (LAYER0 && u.pn >= 8 && u.pn < 12) {
                        const int b = row >> 12, t = row & 4095, ch = (u.pn - 8) * 256 + cl;
                        bf16* vp = VT + ((size_t)(b * DH + ch)) * T + t;
                        const unsigned p0 = cvtpk(v0[0], v0[1]), p1 = cvtpk(v0[2], v0[3]), p2 = cvtpk(v1[0], v1[1]), p3 = cvtpk(v1[2], v1[3]);
                        vp[0 * (size_t)T] = (bf16)(p0 & 0xffff); vp[1 * (size_t)T] = (bf16)(p0 >> 16); vp[2 * (size_t)T] = (bf16)(p1 & 0xffff); vp[3 * (size_t)T] = (bf16)(p1 >> 16);
                        vp[4 * (size_t)T] = (bf16)(p2 & 0xffff); vp[5 * (size_t)T] = (bf16)(p2 >> 16); vp[6 * (size_t)T] = (bf16)(p3 & 0xffff); vp[7 * (size_t)T] = (bf16)(p3 >> 16);
                    } else {
                        bf16* dst;
                        if (LAYER0) {
                            if (u.pn < 4) dst = QB + (size_t)row * DH + u.pn * 256 + cl;
                            else if (u.pn < 8) dst = KB + (size_t)row * DH + (u.pn - 4) * 256 + cl;
                            else dst = Z + (size_t)row * NZ + (u.pn - 12) * 256 + cl;
                        } else dst = O + (size_t)row * ldo + u.pn * 256 + cl;
                        u32x4 w; w.x = cvtpk(v0[0], v0[1]); w.y = cvtpk(v0[2], v0[3]); w.z = cvtpk(v1[0], v1[1]); w.w = cvtpk(v1[2], v1[3]);
                        *(u32x4*)dst = w;
                    }
                }
            }
    }
};
__device__ __forceinline__ int opq(int v) { asm volatile("" : "+s"(v)); return v; }
__device__ __forceinline__ int opqv(int v) { asm volatile("" : "+v"(v)); return v; }
__device__ __forceinline__ unsigned char* wsp(unsigned char* ws, size_t off) { asm volatile("" : "+s"(ws)); return (unsigned char*)((GAS unsigned char*)ws + off); }
#define GEMM_PHASE(EPI, Aptr, Bptr, NN, KK, Eobj) do { pg8::Gemm g_{(const pg8::bf16_t*)(Aptr), (const pg8::bf16_t*)(Bptr), M, (NN), (KK)}; pg8::StaticOrder S_; S_.init(M, (NN), opq((int)gridDim.x), opq((int)blockIdx.x)); \
        pg8::gemm_phase<EPI, pg8::StaticOrder, true, true>(lds, g_, S_, (Eobj)); } while (0)

#define XB_TMO      128
#define XB_XCNT(j)  (256  + 64 * (j))
#define XB_XSUB(j)  (1280 + 64 * (j))
#define XB_XGEN(j)  (2304 + 64 * (j))
#define XB_TOP      3328
#define XB_TOPGEN   3392
#define XCD_BAR_WORDS 3456
#define XB_SPIN_CAP (1u << 18)

__device__ __forceinline__ unsigned xb_ld(unsigned* p)              { return __hip_atomic_load(p, __ATOMIC_RELAXED, __HIP_MEMORY_SCOPE_AGENT); }
__device__ __forceinline__ unsigned xb_add(unsigned* p, unsigned v) { return __hip_atomic_fetch_add(p, v, __ATOMIC_RELAXED, __HIP_MEMORY_SCOPE_AGENT); }
__device__ __forceinline__ unsigned xb_xcc_id() { return (unsigned)__builtin_amdgcn_s_getreg((3 << 11) | 20) & 0xFu; }
#define XB_SPIN(cond, bar) do { unsigned _sp = 0; while (cond) { __builtin_amdgcn_s_sleep(1); \
    if ((++_sp & 255u) == 0u) { if (xb_ld(&(bar)[XB_TMO])) break; if (_sp > XB_SPIN_CAP) { atomicAdd(&(bar)[XB_TMO], 1u); break; } } } } while (0)

struct XcdBarrier {
    unsigned* bar; unsigned x;
    volatile LAS unsigned* st;
};

__device__ __forceinline__ XcdBarrier xcd_barrier_post(unsigned* bar, volatile LAS unsigned* st) {
    XcdBarrier b; b.bar = bar; b.x = xb_xcc_id(); b.st = st;
    if (threadIdx.x == 0) (void)xb_add(&bar[XB_XCNT(b.x)], 1u);
    return b;
}
__device__ __forceinline__ void xcd_barrier_complete(unsigned* bar, unsigned x, unsigned& nloc, unsigned& nx) {
    const unsigned G = gridDim.x * gridDim.y * gridDim.z;
    unsigned sum, cnt, mine, sp = 0u;
    for (;;) {
        sum = 0u; cnt = 0u; mine = 0u;
#pragma unroll
        for (unsigned j = 0; j < 16; ++j) { const unsigned c = xb_ld(&bar[XB_XCNT(j)]); sum += c; cnt += (c > 0u) ? 1u : 0u; mine = (j == x) ? c : mine; }
        if (sum == G) break;
        __builtin_amdgcn_s_sleep(1);
        if ((++sp & 255u) == 0u) { if (xb_ld(&bar[XB_TMO])) break; if (sp > XB_SPIN_CAP) { atomicAdd(&bar[XB_TMO], 1u); break; } }
    }
    nloc = mine > 0u ? mine : 1u; nx = cnt > 0u ? cnt : 1u;
}

__device__ __forceinline__ void xcd_barrier(const XcdBarrier& b) {
    asm volatile("s_waitcnt vmcnt(0)" ::: "memory");
    __syncthreads();
    if (threadIdx.x == 0) {
        unsigned* bar = b.bar;
        __builtin_amdgcn_s_waitcnt(0);
        unsigned nloc = b.st[0], nx = b.st[1];
        if (nloc == 0u) { xcd_barrier_complete(bar, b.x, nloc, nx); b.st[0] = nloc; b.st[1] = nx; }
        const unsigned old = xb_add(&bar[XB_XSUB(b.x)], 1u);
        const unsigned gen = old / nloc;
        if (old + 1u == (gen + 1u) * nloc) {
            __builtin_amdgcn_fence(__ATOMIC_RELEASE, "agent");
            asm volatile("s_waitcnt vmcnt(0)" ::: "memory");
            const unsigned og = xb_add(&bar[XB_TOP], 1u);
            const unsigned tg = og / nx;
            if (og + 1u == (tg + 1u) * nx) xb_add(&bar[XB_TOPGEN], 1u);
            else XB_SPIN(xb_ld(&bar[XB_TOPGEN]) == tg, bar);
            __builtin_amdgcn_fence(__ATOMIC_ACQUIRE, "agent");
            xb_add(&bar[XB_XGEN(b.x)], 1u);
            asm volatile("s_waitcnt vmcnt(0)" ::: "memory");
        } else {
            XB_SPIN(xb_ld(&bar[XB_XGEN(b.x)]) == gen, bar);
            __builtin_amdgcn_fence(__ATOMIC_ACQUIRE, "agent");
            asm volatile("s_waitcnt vmcnt(0)" ::: "memory");
        }
    }
    __syncthreads();
}


constexpr size_t OFF_YRAW = OFF_QB;
constexpr size_t OFF_GG = OFF_VT;
constexpr size_t OFF_BV = OFF_HB;
constexpr int RECF = 384;
static_assert((size_t)NB * 16 * SEGT * RECF * 4 <= SZ_SCANSEG, "segment buffers fit");

__device__ __forceinline__ float quad_sum(float v) {
    v += __builtin_bit_cast(float, __builtin_amdgcn_mov_dpp(__builtin_bit_cast(int, v), 0xB1, 0xF, 0xF, true));
    v += __builtin_bit_cast(float, __builtin_amdgcn_mov_dpp(__builtin_bit_cast(int, v), 0x4E, 0xF, 0xF, true));
    return v;
}
__device__ __forceinline__ void unpack8(const u32x4 w, float* x) { x[0] = bflo(w.x); x[1] = bfhi(w.x); x[2] = bflo(w.y); x[3] = bfhi(w.y); x[4] = bflo(w.z); x[5] = bfhi(w.z); x[6] = bflo(w.w); x[7] = bfhi(w.w); }

__device__ __forceinline__ void qknorm_rows(bf16* QBp, bf16* KBp, int gw, int NGW, int lane) {
    const float* qg = inp(15); const float* kg = inp(16);
    const int d0 = (lane & 3) * 16;
    float gq[16], gk[16];
#pragma unroll
    for (int i = 0; i < 16; ++i) { gq[i] = qg[d0 + i] * 0.125f; gk[i] = kg[d0 + i]; }
    for (int it = gw; it < 2 * M; it += NGW) {
        const bool isk = it >= M; const int row = isk ? it - M : it;
        bf16* p = (isk ? KBp : QBp) + (size_t)row * DH + lane * 16;
        float x[16]; unpack8(*(const u32x4*)p, x); unpack8(*(const u32x4*)(p + 8), x + 8);
        float s = 0.f;
#pragma unroll
        for (int i = 0; i < 16; ++i) s += x[i] * x[i];
        s = quad_sum(s);
        const float rs = __builtin_amdgcn_rsqf(s * (1.0f / 64.0f) + RMS_EPS);
#pragma unroll
        for (int i = 0; i < 16; ++i) x[i] = x[i] * rs * (isk ? gk[i] : gq[i]);
        u32x4 a, b2; a.x = cvtpk(x[0], x[1]); a.y = cvtpk(x[2], x[3]); a.z = cvtpk(x[4], x[5]); a.w = cvtpk(x[6], x[7]);
        b2.x = cvtpk(x[8], x[9]); b2.y = cvtpk(x[10], x[11]); b2.z = cvtpk(x[12], x[13]); b2.w = cvtpk(x[14], x[15]);
        *(u32x4*)p = a; *(u32x4*)(p + 8) = b2;
    }
}

#define MFMA32(a, b, c) __builtin_amdgcn_mfma_f32_32x32x16_bf16((a), (b), (c), 0, 0, 0)
__device__ __forceinline__ int crow(int i, int hh) { return (i & 3) + 8 * (i >> 2) + 4 * hh; }
__device__ __forceinline__ void attn_unit(const bf16* QBp, const bf16* KBp, const bf16* VTp, bf16* MIXp, const float* biasg, int unit, int lane) {
    const int h = unit & 15, c = (unit >> 4) & 63, b = unit >> 10;
    const int r = lane & 31, hh = lane >> 5;
    const float* bias = biasg + h * 192;
    const size_t rowq0 = (size_t)b * T + c * 64;
    bf16x8 qf[2][4];
#pragma unroll
    for (int qt = 0; qt < 2; ++qt)
#pragma unroll
        for (int s = 0; s < 4; ++s) qf[qt][s] = *(const bf16x8*)(QBp + (rowq0 + 32 * qt + r) * DH + h * 64 + 16 * s + 8 * hh);
    f32x16 oacc[2][2];
#pragma unroll
    for (int a = 0; a < 2; ++a)
#pragma unroll
        for (int q = 0; q < 2; ++q)
#pragma unroll
            for (int i = 0; i < 16; ++i) oacc[a][q][i] = 0.f;
    float mrun[2] = {-1e30f, -1e30f}, lrun[2] = {0.f, 0.f};
    const float bconst = bias[191];
    for (int kc = (c < 8 ? 8 - c : 0); kc <= 8; ++kc) {
        const int kch = c - 8 + kc;
        for (int kt = 0; kt < 2; ++kt) {
            const size_t krow = (size_t)b * T + kch * 64 + kt * 32 + r;
            bf16x8 kf[4];
#pragma unroll
            for (int s = 0; s < 4; ++s) kf[s] = *(const bf16x8*)(KBp + krow * DH + h * 64 + 16 * s + 8 * hh);
            bf16x8 vf[2][2];
#pragma unroll
            for (int dt = 0; dt < 2; ++dt)
#pragma unroll
                for (int s2 = 0; s2 < 2; ++s2) {
                    const bf16* vp = VTp + ((size_t)(b * DH + h * 64 + 32 * dt + r)) * T + kch * 64 + kt * 32 + 16 * s2 + 4 * hh;
                    const s16x4 lo = *(const s16x4*)vp, hi = *(const s16x4*)(vp + 8);
                    vf[dt][s2] = (bf16x8){lo[0], lo[1], lo[2], lo[3], hi[0], hi[1], hi[2], hi[3]};
                }
#pragma unroll
            for (int qt = 0; qt < 2; ++qt) {
                f32x16 st;
#pragma unroll
                for (int i = 0; i < 16; ++i) st[i] = 0.f;
#pragma unroll
                for (int s = 0; s < 4; ++s) st = MFMA32(kf[s], qf[qt][s], st);
                if (kc <= 5) {
#pragma unroll
                    for (int i = 0; i < 16; ++i) st[i] += bconst;
                } else {
#pragma unroll
                    for (int i = 0; i < 16; ++i) { int dist = (32 * qt + r) - (kt * 32 + crow(i, hh)) + 64 * (8 - kc); dist = dist < -63 ? -63 : (dist > 128 ? 128 : dist); st[i] += bias[dist + 63]; }
                }
                float mx = st[0];
#pragma unroll
                for (int i = 1; i < 16; ++i) mx = fmaxf(mx, st[i]);
                mx = fmaxf(mx, __shfl_xor(mx, 32));
                const float mnew = fmaxf(mrun[qt], mx), alpha = __expf(mrun[qt] - mnew);
                float ls = 0.f;
#pragma unroll
                for (int i = 0; i < 16; ++i) { st[i] = __expf(st[i] - mnew); ls += st[i]; }
                ls += __shfl_xor(ls, 32);
                lrun[qt] = lrun[qt] * alpha + ls; mrun[qt] = mnew;
#pragma unroll
                for (int dt = 0; dt < 2; ++dt)
#pragma unroll
                    for (int i = 0; i < 16; ++i) oacc[dt][qt][i] *= alpha;
                bf16x8 pk[2];
#pragma unroll
                for (int s2 = 0; s2 < 2; ++s2) { u32x4 w; w.x = cvtpk(st[8 * s2], st[8 * s2 + 1]); w.y = cvtpk(st[8 * s2 + 2], st[8 * s2 + 3]); w.z = cvtpk(st[8 * s2 + 4], st[8 * s2 + 5]); w.w = cvtpk(st[8 * s2 + 6], st[8 * s2 + 7]); pk[s2] = __builtin_bit_cast(bf16x8, w); }
#pragma unroll
                for (int dt = 0; dt < 2; ++dt)
#pragma unroll
                    for (int s2 = 0; s2 < 2; ++s2) oacc[dt][qt] = MFMA32(vf[dt][s2], pk[s2], oacc[dt][qt]);
            }
        }
    }
#pragma unroll
    for (int qt = 0; qt < 2; ++qt) {
        const float inv = 1.0f / lrun[qt];
        bf16* orow = MIXp + (rowq0 + 32 * qt + r) * D + h * 64;
#pragma unroll
        for (int dt = 0; dt < 2; ++dt)
#pragma unroll
            for (int g4 = 0; g4 < 4; ++g4) { u32x2 w; w.x = cvtpk(oacc[dt][qt][4 * g4] * inv, oacc[dt][qt][4 * g4 + 1] * inv); w.y = cvtpk(oacc[dt][qt][4 * g4 + 2] * inv, oacc[dt][qt][4 * g4 + 3] * inv);
                *(u32x2*)(orow + 32 * dt + 8 * g4 + 4 * hh) = w; }
    }
}

__device__ __forceinline__ f32x2 row16_sum2(f32x2 v) {
    float x = v.x, y = v.y;
#define DPPADD(r, ctl) "v_add_f32_dpp " r ", " r ", " r " " ctl " row_mask:0xf bank_mask:0xf bound_ctrl:1\n\t"
    asm volatile("s_nop 1\n\t"
                 DPPADD("%0", "quad_perm:[1,0,3,2]") DPPADD("%1", "quad_perm:[1,0,3,2]") "s_nop 0\n\t"
                 DPPADD("%0", "quad_perm:[2,3,0,1]") DPPADD("%1", "quad_perm:[2,3,0,1]") "s_nop 0\n\t"
                 DPPADD("%0", "row_ror:4") DPPADD("%1", "row_ror:4") "s_nop 0\n\t"
                 DPPADD("%0", "row_ror:8") DPPADD("%1", "row_ror:8")
                 : "+v"(x), "+v"(y));
#undef DPPADD
    return (f32x2){x, y};
}
constexpr int PREP_TB = 16;
constexpr int XB_STRIDE = 528, XB_BYTES = 16 * XB_STRIDE;
constexpr int WL_OFF = 4 * XB_BYTES;
constexpr int RING_OFF = WL_OFF + 32768;
__device__ __forceinline__ void load_lora_lds(LAS unsigned char* lds, int head, int tid) {
    const float* wup = inp(20); const float* aup = inp(22); const float* gup = inp(23);
    for (int e = tid; e < 64 * 32; e += NTHREADS) {
        const int kc = e >> 6, ch = e & 63, c = head * 64 + ch, k0 = 8 * kc;
        const float* src = (k0 < 64) ? (wup + (size_t)k0 * DH) : (k0 < 128) ? (aup + (size_t)(k0 - 64) * DH) : (gup + (size_t)(k0 - 128) * DH);
        float w[8];
#pragma unroll
        for (int i = 0; i < 8; ++i) w[i] = src[(size_t)i * DH + c];
        u32x4 o; o.x = cvtpk(w[0], w[1]); o.y = cvtpk(w[2], w[3]); o.z = cvtpk(w[4], w[5]); o.w = cvtpk(w[6], w[7]);
        *(LAS u32x4*)(lds + WL_OFF + ch * 512 + ((kc ^ (ch & 15)) * 16)) = o;
    }
}
__device__ __forceinline__ void prep_wave_item(const bf16* Zp, float* SEGp, bf16* GGp, bf16* BVp, LAS unsigned char* XB  , const LAS unsigned char* WLT, int seg, int b, int head, int tb, int lane) {
    const int t0 = seg * SEGT + tb * PREP_TB;
    const float* mu = inp(18);
#pragma unroll 2
    for (int it = 0; it < 8; ++it) {
        const int idx = it * 64 + lane, tk = idx >> 5, col8 = (idx & 31) * 8, t = t0 + tk; const size_t row = (size_t)b * T + t;
        float z[8], zp[8];
        unpack8(*(const u32x4*)(Zp + row * NZ + 3072 + col8), z);
        if (t > 0) unpack8(*(const u32x4*)(Zp + (row - 1) * NZ + 3072 + col8), zp); else {
#pragma unroll
            for (int e = 0; e < 8; ++e) zp[e] = 0.f; }
        const f32x4 m0 = *(const f32x4*)(mu + 3072 + col8), m1 = *(const f32x4*)(mu + 3072 + col8 + 4);
        float x[8];
#pragma unroll
        for (int e = 0; e < 8; ++e) { float v = z[e] + (zp[e] - z[e]) * (e < 4 ? m0[e] : m1[e - 4]);
            if (col8 < 64) v = 1.f - 2.f * __builtin_amdgcn_rcpf(__expf(2.f * v) + 1.f); else if (col8 >= 128) v = fast_sigmoid(v);
            x[e] = v; }
        u32x4 o; o.x = cvtpk(x[0], x[1]); o.y = cvtpk(x[2], x[3]); o.z = cvtpk(x[4], x[5]); o.w = cvtpk(x[6], x[7]);
        *(LAS u32x4*)(XB + tk * XB_STRIDE + col8 * 2) = o;
    }
    const int fr = lane & 15, fq = lane >> 4;
    pg8::f32x4 accw[4], acca[4], accg[4];
#pragma unroll
    for (int n = 0; n < 4; ++n) { accw[n] = (pg8::f32x4){0.f, 0.f, 0.f, 0.f}; acca[n] = accw[n]; accg[n] = accw[n]; }
#define LORA_MFMA(acc_, koff_, nks_) _Pragma("unroll") for (int s = 0; s < (nks_); ++s) { \
        const bf16x8 af = *(const LAS bf16x8*)(XB + fr * XB_STRIDE + ((koff_) + 32 * s + 8 * fq) * 2); \
        _Pragma("unroll") for (int n = 0; n < 4; ++n) { const int chn = 16 * n + fr, chunk = ((koff_) >> 3) + 4 * s + fq; \
            const bf16x8 bfr = *(const LAS bf16x8*)(WLT + chn * 512 + ((chunk ^ fr) * 16)); acc_[n] = __builtin_amdgcn_mfma_f32_16x16x32_bf16(af, bfr, acc_[n], 0, 0, 0); } }
    LORA_MFMA(accw, 0, 2)
    LORA_MFMA(acca, 64, 2)
    LORA_MFMA(accg, 128, 4)
#undef LORA_MFMA
    const int tq = t0 + 4 * fq;
    float kkv[4][4], kpv[4][4], rrv[4][4], vvv[4][4], av[4][4], dec[4][4], rkc[4];
#pragma unroll
    for (int n = 0; n < 4; ++n) {
        const int c = head * 64 + 16 * n + fr;
        const float mur = mu[c], muk = mu[DH + c], muv = mu[2 * DH + c];
        const float w0c = inp(19)[c], a0c = inp(21)[c], kkc = inp(24)[c], kac = inp(25)[c]; rkc[n] = inp(26)[c];
        float zr_p = 0.f, zk_p = 0.f, zv_p = 0.f;
        if (tq > 0) { const size_t rowp = (size_t)b * T + tq - 1; zr_p = bf2f(Zp[rowp * NZ + c]); zk_p = bf2f(Zp[rowp * NZ + DH + c]); zv_p = bf2f(Zp[rowp * NZ + 2 * DH + c]); }
#pragma unroll
        for (int j = 0; j < 4; ++j) {
            const size_t row = (size_t)b * T + tq + j;
            const float zr = bf2f(Zp[row * NZ + c]), zk = bf2f(Zp[row * NZ + DH + c]), zv = bf2f(Zp[row * NZ + 2 * DH + c]);
            const float rr = zr + (zr_p - zr) * mur, kk0 = zk + (zk_p - zk) * muk, vv = zv + (zv_p - zv) * muv;
            zr_p = zr; zk_p = zk; zv_p = zv;
            const float wl = -(w0c + accw[n][j]);
            const float sp = fmaxf(wl, 0.f) + __logf(1.f + __expf(-fabsf(wl)));
            dec[n][j] = __expf(-__expf(-sp - 0.5f));
            const float a = fast_sigmoid(a0c + acca[n][j]);
            av[n][j] = a; kkv[n][j] = kk0 * kkc; kpv[n][j] = kk0 * (1.f + (a - 1.f) * kac); rrv[n][j] = rr; vvv[n][j] = vv;
        }
    }
#pragma unroll
    for (int j = 0; j < 4; ++j) {
        float n2 = 0.f, bo = 0.f;
#pragma unroll
        for (int n = 0; n < 4; ++n) { n2 += kkv[n][j] * kkv[n][j]; bo += rrv[n][j] * kpv[n][j] * rkc[n]; }
        const f32x2 red = row16_sum2((f32x2){n2, bo});
        const float inv = 1.0f / fmaxf(sqrtf(red.x), 1e-12f), bonus = red.y;
        const int t = tq + j; const size_t row = (size_t)b * T + t;
        float* rec = SEGp + ((size_t)((((seg & 1) * NB + b) * 16 + head) * SEGT + (t - seg * SEGT))) * RECF;
#pragma unroll
        for (int n = 0; n < 4; ++n) {
            const int i = 16 * n + fr, c = head * 64 + i; const float kk = kkv[n][j] * inv;
            rec[i] = -kk; rec[64 + i] = dec[n][j]; rec[128 + i] = kk * av[n][j]; rec[192 + i] = kpv[n][j]; rec[256 + i] = rrv[n][j]; rec[320 + i] = vvv[n][j];
            GGp[row * DH + c] = (bf16)(cvtpk(accg[n][j], 0.f) & 0xffff); BVp[row * DH + c] = (bf16)(cvtpk(bonus * vvv[n][j], 0.f) & 0xffff);
        }
    }
}

__device__ __forceinline__ float dot4(const f32x4 a, const f32x4 b) { return (a[0] * b[0] + a[1] * b[1]) + (a[2] * b[2] + a[3] * b[3]); }
__device__ __forceinline__ float row16_sum(float v) {
    v += __builtin_bit_cast(float, __builtin_amdgcn_mov_dpp(__builtin_bit_cast(int, v), 0xB1, 0xF, 0xF, true));
    v += __builtin_bit_cast(float, __builtin_amdgcn_mov_dpp(__builtin_bit_cast(int, v), 0x4E, 0xF, 0xF, true));
    v += __builtin_bit_cast(float, __builtin_amdgcn_mov_dpp(__builtin_bit_cast(int, v), 0x124, 0xF, 0xF, true));
    v += __builtin_bit_cast(float, __builtin_amdgcn_mov_dpp(__builtin_bit_cast(int, v), 0x128, 0xF, 0xF, true));
    return v;
}
template <bool HOT = false> __device__ __forceinline__ void scan_segment(const float* SEGp, float* Yp, LAS unsigned char* lds, int seg, int hidx, int rg, int wv, int lane, f32x4& S) {
    __builtin_amdgcn_s_setprio(3);
    const int kg = lane & 15, rw = lane >> 4;
    const int b = hidx >> 4, h = hidx & 15;
    constexpr int BS = 4, NBATCH = SEGT / BS;
    LAS float* RING = (LAS float*)(lds + RING_OFF) + wv * (2 * BS * 384);
    const float* recs = SEGp + ((size_t)((((seg & 1) * NB + b) * 16 + h) * SEGT)) * RECF;
    const int vrow = rg * 16 + wv * 4;
    float* yout = Yp + ((size_t)b * T + seg * SEGT) * DH + h * 64 + vrow + rw;
    const int k0 = kg * 4;
#pragma unroll
    for (int j = 0; j < BS; ++j) { const float* rp = recs + (size_t)j * RECF;
        *(LAS f32x4*)(RING + j * 384 + 4 * lane) = *(const f32x4*)(rp + 4 * lane);
        *(LAS f32x4*)(RING + j * 384 + 256 + 4 * (lane & 31)) = *(const f32x4*)(rp + 256 + 4 * (lane & 31)); }
#define LOADOPS(dst, dvv, slot_) do { const LAS float* o_ = RING + (slot_) * 384; \
        _Pragma("unroll") for (int q_ = 0; q_ < 5; ++q_) dst[q_] = *(const LAS f32x4*)(o_ + k0 + q_ * 64); dvv = o_[320 + vrow + rw]; } while (0)
    f32x4 cur[5]; float cvv;
    LOADOPS(cur, cvv, 0);
    float sa = row16_sum(dot4(S, cur[0]));
    for (int B = 0; B < NBATCH; ++B) {
        f32x4 pfa[BS], pfb[BS];
        const bool more = (B + 1 < NBATCH);
        if (more) {
#pragma unroll
            for (int j = 0; j < BS; ++j) { const float* rp = recs + (size_t)(BS * (HOT ? (B & 1) : (B + 1)) + j) * RECF;
                pfa[j] = *(const f32x4*)(rp + 4 * lane); pfb[j] = *(const f32x4*)(rp + 256 + 4 * (lane & 31)); }
        }
        float ys[BS];
#pragma unroll
        for (int j = 0; j < BS; ++j) {
            const int slot = (B & 1) * BS + j;
            if (j == BS - 1 && more) {
#pragma unroll
                for (int jj = 0; jj < BS; ++jj) { LAS float* d = RING + (((B + 1) & 1) * BS + jj) * 384;
                    *(LAS f32x4*)(d + 4 * lane) = pfa[jj]; *(LAS f32x4*)(d + 256 + 4 * (lane & 31)) = pfb[jj]; }
            }
            f32x4 nxt[5]; float nvv = 0.f;
            if (j < BS - 1) LOADOPS(nxt, nvv, slot + 1);
            else if (more) LOADOPS(nxt, nvv, ((B + 1) & 1) * BS);
            else {
#pragma unroll
                for (int q = 0; q < 5; ++q) nxt[q] = cur[q]; }
            S = (S * cur[1] + cvv * cur[3]) + sa * cur[2];
            f32x2 pr = {dot4(S, cur[4]), dot4(S, nxt[0])};
            pr = row16_sum2(pr);
            ys[j] = pr.x; sa = pr.y;
#pragma unroll
            for (int q = 0; q < 5; ++q) cur[q] = nxt[q];
            cvv = nvv;
        }
        if (kg == 0) {
#pragma unroll
            for (int j = 0; j < BS; ++j) yout[(size_t)(BS * B + j) * DH] = ys[j]; }
    }
#undef LOADOPS
    __builtin_amdgcn_s_setprio(0);
}

__device__ __forceinline__ float half_sum(float v) {
#pragma unroll
    for (int o = 1; o < 32; o <<= 1) v += __shfl_xor(v, o);
    return v;
}
__device__ __forceinline__ void rwkv_post(const float* Yp, const bf16* GGp, const bf16* BVp, bf16* MIXp, int gw, int NGW, int lane) {
    const float* lw = inp(27); const float* lb = inp(28);
    const int hsel = lane >> 4, cq = lane & 15;
    for (int it = gw; it < M * 4; it += NGW) {
        const int row = it >> 2, c = (4 * (it & 3) + hsel) * 64 + 4 * cq;
        const f32x4 y = *(const f32x4*)(Yp + (size_t)row * DH + c);
        const f32x2 red = row16_sum2((f32x2){(y[0] + y[1]) + (y[2] + y[3]), (y[0] * y[0] + y[1] * y[1]) + (y[2] * y[2] + y[3] * y[3])});
        const float mean = red.x * (1.0f / 64.0f), var = fmaxf(red.y * (1.0f / 64.0f) - mean * mean, 0.f);
        const float rs = __builtin_amdgcn_rsqf(var + 64e-5f);
        const u32x2 bv = *(const u32x2*)(BVp + (size_t)row * DH + c), gg = *(const u32x2*)(GGp + (size_t)row * DH + c);
        const f32x4 w4 = *(const f32x4*)(lw + c), b4 = *(const f32x4*)(lb + c);
        const float o0 = ((y[0] - mean) * rs * w4[0] + b4[0] + bflo(bv.x)) * bflo(gg.x), o1 = ((y[1] - mean) * rs * w4[1] + b4[1] + bfhi(bv.x)) * bfhi(gg.x);
        const float o2 = ((y[2] - mean) * rs * w4[2] + b4[2] + bflo(bv.y)) * bflo(gg.y), o3 = ((y[3] - mean) * rs * w4[3] + b4[3] + bfhi(bv.y)) * bfhi(gg.y);
        u32x2 o; o.x = cvtpk(o0, o1); o.y = cvtpk(o2, o3);
        *(u32x2*)(MIXp + (size_t)row * D + DH + c) = o;
    }
}

__device__ __forceinline__ float gelu_tanh(float x) {
    const float t = 0.7978845608028654f * (x + 0.044715f * x * x * x);
    const float e = __expf(2.f * t);
    const float th = 1.f - 2.f * __builtin_amdgcn_rcpf(e + 1.f);
    return 0.5f * x * (1.f + th);
}
__device__ __forceinline__ void s5_unit(const bf16* U, bf16* YS, LAS unsigned char* lds, int b, int g, int tid) {
    constexpr int CT = 128;
    const int lane = tid & 63, wv = tid >> 6, fr = lane & 15, fq = lane >> 4;
    const int pw = wv & 3, half = wv >> 2, p = 16 * pw + fr, seg = 4 * half + fq;
    LAS bf16* usb0 = (LAS bf16*)lds;
    LAS float* E = (LAS float*)(lds + 2 * CT * 32);
    LAS float* CAR = E + 8 * 64 * 2;
    LAS bf16* Hb0 = (LAS bf16*)(CAR + 128);
    const float* bre_p = inp(34); const float* bim_p = inp(35); const float* cre_p = inp(36); const float* cim_p = inp(37); const float* dsk_p = inp(38);
    const float lr = inp(31)[g * 64 + p], li = inp(32)[g * 64 + p], dt = expf(inp(33)[g]);
    const float mag = expf(lr * dt), are = mag * cosf(li * dt), aim = mag * sinf(li * dt);
    const float den = lr * lr + li * li;
    const float zre = ((are - 1.f) * lr + aim * li) / den, zim = (aim * lr - (are - 1.f) * li) / den;
    bf16x8 bfr_re, bfr_im;
    {
        float wr[8], wi[8];
#pragma unroll
        for (int i = 0; i < 8; ++i) { const int c = 8 * (fq & 1) + i; const float br = bre_p[(g * 64 + p) * 16 + c], bi = bim_p[(g * 64 + p) * 16 + c];
            wr[i] = (fq < 2) ? (zre * br - zim * bi) : 0.f; wi[i] = (fq < 2) ? (zre * bi + zim * br) : 0.f; }
        u32x4 a, c2; a.x = cvtpk(wr[0], wr[1]); a.y = cvtpk(wr[2], wr[3]); a.z = cvtpk(wr[4], wr[5]); a.w = cvtpk(wr[6], wr[7]);
        c2.x = cvtpk(wi[0], wi[1]); c2.y = cvtpk(wi[2], wi[3]); c2.z = cvtpk(wi[4], wi[5]); c2.w = cvtpk(wi[6], wi[7]);
        bfr_re = __builtin_bit_cast(bf16x8, a); bfr_im = __builtin_bit_cast(bf16x8, c2);
    }
    float pwr[16], pwi[16];
    pwr[0] = are; pwi[0] = aim;
#pragma unroll
    for (int q = 1; q < 16; ++q) { pwr[q] = pwr[q - 1] * are - pwi[q - 1] * aim; pwi[q] = pwr[q - 1] * aim + pwi[q - 1] * are; }
    bf16x8 cfrag[4];
#pragma unroll
    for (int s = 0; s < 4; ++s) { const int kk0 = 32 * s + 8 * fq; const float* src = (kk0 < 64) ? (cre_p + g * 1024 + fr * 64 + kk0) : (cim_p + g * 1024 + fr * 64 + (kk0 - 64)); const float sg = (kk0 < 64) ? 1.f : -1.f;
        const f32x4 c0v = *(const f32x4*)src, c1v = *(const f32x4*)(src + 4); u32x4 w; w.x = cvtpk(sg * c0v[0], sg * c0v[1]); w.y = cvtpk(sg * c0v[2], sg * c0v[3]); w.z = cvtpk(sg * c1v[0], sg * c1v[1]); w.w = cvtpk(sg * c1v[2], sg * c1v[3]);
        cfrag[s] = __builtin_bit_cast(bf16x8, w); }
    const float dch = dsk_p[g * 16 + fr];
    if (tid < 64) { CAR[2 * tid] = 0.f; CAR[2 * tid + 1] = 0.f; }
    u32x4 unext = {0u, 0u, 0u, 0u};
    if (tid < 2 * CT) unext = *(const u32x4*)(U + (size_t)(b * T + (tid >> 1)) * DH + g * 16 + (tid & 1) * 8);
    __syncthreads();
    for (int ch = 0; ch < T / CT; ++ch) {
        const int row0 = b * T + ch * CT;
        LAS bf16* usb = usb0 + (ch & 1) * (CT * 16); LAS bf16* Hb = Hb0 + (ch & 1) * (CT * 136);
        if (tid < 2 * CT) {
            const int t = tid >> 1, hf = tid & 1;
            *(LAS u32x4*)(usb + t * 16 + hf * 8) = unext;
            if (ch + 1 < T / CT) unext = *(const u32x4*)(U + (size_t)(row0 + CT + t) * DH + g * 16 + hf * 8);
        }
        __syncthreads();
        float hr[16], hi[16]; float sr = 0.f, si = 0.f;
#pragma unroll
        for (int m = 0; m < 4; ++m) {
            const int tokA = 64 * half + 16 * (fr >> 2) + 4 * m + (fr & 3);
            bf16x8 af = {0, 0, 0, 0, 0, 0, 0, 0};
            if (fq < 2) af = *(const LAS bf16x8*)(usb + tokA * 16 + 8 * fq);
            const pg8::f32x4 z4 = {0.f, 0.f, 0.f, 0.f};
            const pg8::f32x4 ar = __builtin_amdgcn_mfma_f32_16x16x32_bf16(af, bfr_re, z4, 0, 0, 0);
            const pg8::f32x4 ai = __builtin_amdgcn_mfma_f32_16x16x32_bf16(af, bfr_im, z4, 0, 0, 0);
#pragma unroll
            for (int j = 0; j < 4; ++j) { const float nr = are * sr - aim * si + ar[j], ni = are * si + aim * sr + ai[j]; sr = nr; si = ni; hr[4 * m + j] = sr; hi[4 * m + j] = si; }
        }
        E[(seg * 64 + p) * 2] = sr; E[(seg * 64 + p) * 2 + 1] = si;
        __syncthreads();
        float cr = CAR[2 * p], ci = CAR[2 * p + 1];
        for (int s = 0; s < seg; ++s) { const float er = E[(s * 64 + p) * 2], ei = E[(s * 64 + p) * 2 + 1];
            const float nr = pwr[15] * cr - pwi[15] * ci + er, ni = pwr[15] * ci + pwi[15] * cr + ei; cr = nr; ci = ni; }
#pragma unroll
        for (int q = 0; q < 16; ++q) {
            const float fr_ = hr[q] + pwr[q] * cr - pwi[q] * ci, fi_ = hi[q] + pwr[q] * ci + pwi[q] * cr;
            { const unsigned pkd = cvtpk(fr_, fi_); Hb[(seg * 16 + q) * 136 + p] = (bf16)(pkd & 0xffff); Hb[(seg * 16 + q) * 136 + 64 + p] = (bf16)(pkd >> 16); }
            if (q == 15) { hr[15] = fr_; hi[15] = fi_; }
        }
        __syncthreads();
        if (seg == 7) { CAR[2 * p] = hr[15]; CAR[2 * p + 1] = hi[15]; }
        {
            pg8::f32x4 acc = {0.f, 0.f, 0.f, 0.f};
#pragma unroll
            for (int s = 0; s < 4; ++s) { const bf16x8 a = *(const LAS bf16x8*)(Hb + (wv * 16 + fr) * 136 + 32 * s + 8 * fq); acc = __builtin_amdgcn_mfma_f32_16x16x32_bf16(a, cfrag[s], acc, 0, 0, 0); }
#pragma unroll
            for (int j = 0; j < 4; ++j) { const int t = wv * 16 + 4 * fq + j; const float y = acc[j] + dch * bf2f(usb[t * 16 + fr]);
                YS[(size_t)(row0 + t) * DH + g * 16 + fr] = (bf16)(cvtpk(gelu_tanh(y), 0.f) & 0xffff); }
        }
    }
    __syncthreads();
}

__global__ void __launch_bounds__(NTHREADS, 2) fwd_megakernel(Params P) {
    extern __shared__ __attribute__((aligned(16))) unsigned char lds_raw[];
    cg::grid_group grid = cg::this_grid();
    LAS unsigned char* lds = (LAS unsigned char*)lds_raw;
    const int tid = threadIdx.x, lane = tid & 63, wave = __builtin_amdgcn_readfirstlane(tid >> 6);
    const int G = gridDim.x, bid = blockIdx.x;
    const int gw = bid * NWAVES + wave, NGW = G * NWAVES;
    unsigned char* ws = P.ws;
#define OUTP ((float*)(GAS float*)P.out)
#ifndef REP_SYNC
#define REP_SYNC 0
#endif
#ifndef REP_SCAN
#define REP_SCAN 1
#endif
#ifndef REP_PREP
#define REP_PREP 1
#endif
#ifndef REP_P0
#define REP_P0 1
#endif
#ifndef REP_GU
#define REP_GU 1
#endif
#ifndef REP_RWKV
#define REP_RWKV 1
#endif
#ifndef REP_ATT
#define REP_ATT 1
#endif
#ifndef REP_S5
#define REP_S5 1
#endif
#ifndef REP_INPROJ
#define REP_INPROJ 1
#endif
    { volatile LAS unsigned* st0 = (volatile LAS unsigned*)(lds + 131072 + 64); if (threadIdx.x < 2) st0[threadIdx.x] = 0u; __syncthreads(); }
    const XcdBarrier xbar = xcd_barrier_post((unsigned*)(GAS unsigned*)(ws + OFF_BAR), (volatile LAS unsigned*)(lds + 131072 + 64));
#define GSYNC() xcd_barrier(xbar)
#define TICK(k) do { } while (0)
#define HB ((bf16*)wsp(ws, OFF_HB))
#define HB2 ((bf16*)wsp(ws, OFF_SCAN))
#define PB ((bf16*)wsp(ws, OFF_PB))
#define SSP(j) ((float*)wsp(ws, OFF_SS + (size_t)(j) * M * 4))
#define ACT ((bf16*)wsp(ws, OFF_R))
#define MIX ((bf16*)wsp(ws, OFF_MIX))
#define QB ((bf16*)wsp(ws, OFF_QB))
#define KB ((bf16*)wsp(ws, OFF_KB))
#define VT ((bf16*)wsp(ws, OFF_VT))
#define ZB ((bf16*)wsp(ws, OFF_Z))
#define UB ((bf16*)wsp(ws, OFF_U))
#define YS ((bf16*)wsp(ws, OFF_YS))
    for (int rep = 0; rep < REP_P0; ++rep) { if (rep) grid.sync(); const int t_ = opqv((int)threadIdx.x), wv_ = __builtin_amdgcn_readfirstlane(t_ >> 6); p0_prologue(ws, lds, opq((int)blockIdx.x) * NWAVES + wv_, opq((int)gridDim.x) * NWAVES, wv_, t_ & 63); }
    if (P.ws == nullptr) grid.sync();
    GSYNC(); TICK(0);

    for (int rs_ = 0; rs_ < REP_SYNC; ++rs_) GSYNC();
    for (int l = 0; l < 2; ++l) {
        const float* hin0 = (l == 0) ? inp(0) : OUTP;
        for (int rep = 0; rep < ((l == 0) ? REP_GU : 1); ++rep) { if (rep) GSYNC(); EpiSwiGLU E{ACT, SSP(4 * l)}; GEMM_PHASE(EpiSwiGLU, (l == 0) ? HB : HB2, wsp(ws, OFF_WGU1) + l * SZ_WGU, 2 * DFF, D, E); }
        GSYNC(); TICK(1);
        { EpiRes<0> E{hin0, OUTP, HB, SSP(4 * l + 1), 0.5f, nullptr, nullptr}; GEMM_PHASE(EpiRes<0>, ACT, wsp(ws, OFF_WD1) + l * SZ_WD, D, DFF, E); }
        GSYNC(); TICK(2);
        if (l == 0) {
            for (int rep = 0; rep < REP_INPROJ; ++rep) { if (rep) GSYNC(); EpiStore<true> E{SSP(4 * l + 1), nullptr, 0, QB, KB, VT, ZB}; GEMM_PHASE(EpiStore<true>, HB, wsp(ws, OFF_WIN0), NIN0, D, E); }
            GSYNC(); TICK(3);
            #define HMAP const int x_ = bid_ & 7, y_ = bid_ >> 3, rg_ = y_ & 3, hidx_ = (y_ >> 2) * 8 + x_;
            #define OPQ_IDS const int t_ = opqv((int)threadIdx.x), ln_ = t_ & 63, bid_ = opq((int)blockIdx.x), G_ = opq((int)gridDim.x), gw_ = bid_ * NWAVES + __builtin_amdgcn_readfirstlane(t_ >> 6), NGW_ = G_ * NWAVES; (void)ln_; (void)gw_; (void)NGW_;
            { OPQ_IDS qknorm_rows(QB, KB, gw_, NGW_, ln_); }
            GSYNC(); TICK(4);
            for (int rep = 0; rep < REP_ATT; ++rep) { if (rep) GSYNC(); OPQ_IDS const float* biasg = inp(17);
#pragma unroll 1
            for (int k2_ = 0; ; ++k2_) { const int v_ = 2 * gw_ + (k2_ & 1) + (k2_ >> 1) * 2 * NGW_; if (v_ >= NB * 64 * 16) break; const int bh_ = v_ >> 6, c_ = v_ & 63;
                attn_unit(QB, KB, VT, MIX, biasg, (((bh_ >> 4) * 64 + c_) << 4) | (bh_ & 15), ln_); } }
            GSYNC(); TICK(4);
            { OPQ_IDS HMAP load_lora_lds(lds, hidx_ & 15, t_); __syncthreads(); }
            for (int rep = 0; rep < REP_RWKV; ++rep) { f32x4 Sst = {0.f, 0.f, 0.f, 0.f};
              for (int s = 0; s <= NSEG; ++s) {
                if (REP_SCAN > 1 && s >= 1) { OPQ_IDS HMAP f32x4 Sd = Sst; if ((t_ >> 6) < 4) scan_segment<(REP_SCAN > 2)>((const float*)wsp(ws, OFF_SCAN), (float*)wsp(ws, OFF_YRAW), lds, s - 1, hidx_, rg_, __builtin_amdgcn_readfirstlane(t_ >> 6), ln_, Sd); }
                if (s >= 1) { OPQ_IDS HMAP if ((t_ >> 6) < 4) scan_segment((const float*)wsp(ws, OFF_SCAN), (float*)wsp(ws, OFF_YRAW), lds, s - 1, hidx_, rg_, __builtin_amdgcn_readfirstlane(t_ >> 6), ln_, Sst); }
                if (s < NSEG) for (int rp_ = 0; rp_ < REP_PREP; ++rp_) { OPQ_IDS HMAP const int wv_ = __builtin_amdgcn_readfirstlane(t_ >> 6), pw_ = wv_ - 4;
                  if (s == 0) { for (int tb_ = rg_ * 8 + wv_; tb_ < SEGT / PREP_TB; tb_ += 32)
                      prep_wave_item(ZB, (float*)wsp(ws, OFF_SCAN), (bf16*)wsp(ws, OFF_GG), (bf16*)wsp(ws, OFF_BV), (wv_ < 4) ? (lds + RING_OFF + wv_ * XB_BYTES) : (lds + pw_ * XB_BYTES), lds + WL_OFF, s, hidx_ >> 4, hidx_ & 15, tb_, ln_); }
                  else if (pw_ >= 0) for (int tb_ = rg_ * 4 + pw_; tb_ < SEGT / PREP_TB; tb_ += 16) prep_wave_item(ZB, (float*)wsp(ws, OFF_SCAN), (bf16*)wsp(ws, OFF_GG), (bf16*)wsp(ws, OFF_BV), lds + pw_ * XB_BYTES, lds + WL_OFF, s, hidx_ >> 4, hidx_ & 15, tb_, ln_); }
                GSYNC(); TICK(5);
              } }
            { OPQ_IDS rwkv_post((const float*)wsp(ws, OFF_YRAW), (const bf16*)wsp(ws, OFF_GG), (const bf16*)wsp(ws, OFF_BV), MIX, gw_, NGW_, ln_); }
            GSYNC(); TICK(5);
            { EpiRes<0> E{OUTP, OUTP, HB, SSP(4 * l + 2), 1.0f, nullptr, nullptr}; GEMM_PHASE(EpiRes<0>, MIX, wsp(ws, OFF_WOUT0), D, D, E); }
            GSYNC(); TICK(7);
        } else {
            { EpiStore<false> E{SSP(4 * l + 1), UB, DH, nullptr, nullptr, nullptr, nullptr}; GEMM_PHASE(EpiStore<false>, HB, wsp(ws, OFF_WSIN), DH, D, E); }
            GSYNC(); TICK(7);
            for (int rep = 0; rep < REP_S5; ++rep) { if (rep) GSYNC(); OPQ_IDS for (int un = bid_; un < NB * 64; un += G_) s5_unit(UB, YS, lds, un >> 6, un & 63, t_); } GSYNC(); TICK(6);
            { EpiRes<1> E{OUTP, OUTP, HB, SSP(4 * l + 2), 1.0f, nullptr, nullptr}; GEMM_PHASE(EpiRes<1>, YS, wsp(ws, OFF_WSOUT), 2 * D, DH, E); }
            GSYNC(); TICK(7);
        }
        { EpiSwiGLU E{ACT, SSP(4 * l + 2)}; GEMM_PHASE(EpiSwiGLU, HB, wsp(ws, OFF_WGU2) + l * SZ_WGU, 2 * DFF, D, E); }
        GSYNC(); TICK(1);
        { EpiRes<0> E{OUTP, OUTP, HB, SSP(4 * l + 3), 0.5f, nullptr, nullptr}; GEMM_PHASE(EpiRes<0>, ACT, wsp(ws, OFF_WD2) + l * SZ_WD, D, DFF, E); }
        { EpiStore<false> E{nullptr, MIX, D, nullptr, nullptr, nullptr, nullptr}; GEMM_PHASE(EpiStore<false>, PB + (size_t)l * M * DPLE, wsp(ws, OFF_WPP) + l * SZ_WPP, D, DPLE, E); }
        GSYNC(); TICK(2);
        { EpiRes<2> E{OUTP, OUTP, (l == 0) ? HB2 : (bf16*)nullptr  , (l == 0) ? (SSP(4 * l + 4)) : nullptr, 1.0f, SSP(4 * l + 3), MIX}; GEMM_PHASE(EpiRes<2>, HB, wsp(ws, OFF_WPG) + l * SZ_WPG, D, D, E); }
        if (l == 0) GSYNC(); TICK(7);
    }
}

extern "C" void kernel_launch(void* const* d_in, const int* in_sizes, int n_in, void* d_out, int out_size, void* d_ws, size_t ws_size, hipStream_t stream) {
    static int grid_blocks = 0;
    if (grid_blocks == 0) {
        int dev = 0, cus = 0, per_cu = 0;
        hipGetDevice(&dev); hipDeviceGetAttribute(&cus, hipDeviceAttributeMultiprocessorCount, dev);
        hipFuncSetAttribute((const void*)fwd_megakernel, hipFuncAttributeMaxDynamicSharedMemorySize, LDS_BYTES);
        hipOccupancyMaxActiveBlocksPerMultiprocessor(&per_cu, (const void*)fwd_megakernel, NTHREADS, LDS_BYTES);
        if (per_cu < 1) { fprintf(stderr, "occupancy query returned %d\n", per_cu); per_cu = 1; }
        grid_blocks = cus * per_cu;
        if (ws_size < WS_END) fprintf(stderr, "workspace too small: %zu < %zu\n", ws_size, (size_t)WS_END);
    }
    (void)hipMemsetAsync((unsigned char*)d_ws + OFF_BAR, 0, BAR_BYTES, stream);
    Params p{};
    unsigned char* ws = (unsigned char*)d_ws;
    for (int i = 0; i < 40; ++i) p.in[i] = (const float*)d_in[i];
    p.out = (float*)d_out; p.ws = ws;

    void* args[] = {&p};
    hipError_t e = hipLaunchCooperativeKernel((const void*)fwd_megakernel, dim3(grid_blocks), dim3(NTHREADS), args, LDS_BYTES, stream);
    if (e != hipSuccess) fprintf(stderr, "cooperative launch failed: %s (grid %d)\n", hipGetErrorString(e), grid_blocks);
}
```

```cpp
#include <hip/hip_runtime.h>
#include <hip/hip_cooperative_groups.h>
#include <cstdio>
#include <cstdint>
namespace cg = cooperative_groups;
namespace pg8 {
#define PG8_LAS __attribute__((address_space(3)))
typedef unsigned short bf16_t;
typedef short bf16x8 __attribute__((ext_vector_type(8)));
typedef float f32x4 __attribute__((ext_vector_type(4)));
typedef unsigned u32x4 __attribute__((ext_vector_type(4)));
constexpr int BM = 256, BK = 64, HALF = 128, HTB = HALF * BK * 2  , STAGE_BYTES = 8 * HTB, NXCD = 8, WGM = 4;

__host__ __device__ __forceinline__ int lds_byte(int r, int c) { const int st = (r >> 4) * 2 + (c >> 5), rr = r & 15, cc = c & 31, ob = rr * 64 + cc * 2; return st * 1024 + (ob ^ (((ob >> 9) & 1) << 5)); }
__host__ __device__ __forceinline__ void stage_rc(int b, int& R, int& C) { const int st = b / 1024, sb = b % 1024, swz = sb ^ (((sb >> 9) & 1) << 5); R = (st >> 1) * 16 + swz / 64; C = (st & 1) * 32 + (swz % 64) / 2; }
__host__ __device__ __forceinline__ int perm32(int rho) { const int n = rho >> 4, i = rho & 15; return 8 * (i >> 2) + 4 * n + (i & 3); }

struct Unit { int pm, pn; };
struct Gemm { const bf16_t* A; const bf16_t* Bt; int M, N, K; };

struct StaticOrder {
    int nM, nN, nwg, G, c;
    __host__ __device__ void init(int M, int N, int G_, int c_) { nM = M / BM; nN = N / BM; nwg = nM * nN; G = G_; c = c_; }
    __host__ __device__ bool next(int i, Unit& u) const {
        const long L = (long)i * G + c; if (L >= nwg) return false;
        int wgid = (int)L; { const int q = nwg / NXCD, r = nwg % NXCD, xcd = wgid % NXCD, off = wgid / NXCD; wgid = (xcd < r ? xcd * (q + 1) : r * (q + 1) + (xcd - r) * q) + off; }
        const int nig = WGM * nN, gid = wgid / nig, fm = gid * WGM, gsz = (nM - fm) < WGM ? (nM - fm) : WGM;
        u.pm = fm + ((wgid % nig) % gsz); u.pn = (wgid % nig) / gsz; return true;
    }
    __device__ __forceinline__ void a_ready(const Unit&) const {}
    __device__ __forceinline__ void done(const Unit&) const {}
};

__device__ __forceinline__ unsigned cvt_pk_bf16(float lo, float hi) { unsigned r; asm volatile("v_cvt_pk_bf16_f32 %0, %1, %2" : "=v"(r) : "v"(lo), "v"(hi)); return r; }
template <class Epi, class Sched, bool ALIGN_EPI = false, bool SP2 = false>
__device__ __forceinline__ void gemm_phase(PG8_LAS unsigned char* lds, const Gemm g, const Sched& S, const Epi& E) {
    int tid_o = threadIdx.x; asm volatile("" : "+v"(tid_o));
    const int tid = tid_o, wid = __builtin_amdgcn_readfirstlane(tid >> 6), lane = tid & 63, wr = wid >> 2, wc = wid & 3, fr = lane & 15, fq = lane >> 4;
    const int K = g.K, nt = K / BK;
    unsigned voffA[2], voffB[2];
#pragma unroll
    for (int i = 0; i < 2; ++i) { int R, C; stage_rc(tid * 16 + i * 8192, R, C); const int Rb = Epi::PERM ? ((R & ~31) + perm32(R & 31)) : R;
        voffA[i] = (unsigned)(R * K + C) * 2u; voffB[i] = (unsigned)(Rb * K + C) * 2u; }
    const size_t kstep = (size_t)(BK * 2);
    const size_t hstep = (size_t)HALF * K * 2;
    const size_t tstep = 2 * hstep;
    const unsigned ldsw = (unsigned)wid * 1024u;
    const int aoff = lds_byte(wr * 64 + fr, fq * 8), boff = lds_byte(wc * 32 + fr, fq * 8);
#define PG8_SA(b, h) (((b) * 2 + (h)) * HTB)
#define PG8_SB(b, h) ((4 + (b) * 2 + (h)) * HTB)
#define PG8_STAGE(bufoff, gbase, voff) do { _Pragma("unroll") for (int _i = 0; _i < 2; ++_i) \
        __builtin_amdgcn_global_load_lds((const unsigned*)((const char*)(gbase) + (voff)[_i]), (PG8_LAS unsigned*)(lds + (bufoff) + ldsw + _i * 8192), 16, 0, 0); } while (0)
#define PG8_LDA(dst, b, h) do { _Pragma("unroll") for (int m = 0; m < 4; ++m) _Pragma("unroll") for (int k = 0; k < 2; ++k) dst[m][k] = *(const PG8_LAS bf16x8*)(lds + PG8_SA(b, h) + aoff + m * 2048 + k * 1024); } while (0)
#define PG8_LDB(dst, b, h) do { _Pragma("unroll") for (int n = 0; n < 2; ++n) _Pragma("unroll") for (int k = 0; k < 2; ++k) dst[n][k] = *(const PG8_LAS bf16x8*)(lds + PG8_SB(b, h) + boff + n * 2048 + k * 1024); } while (0)
#define PG8_MMA(ai, bj, At, Bt) do { __builtin_amdgcn_s_setprio(1); _Pragma("unroll") for (int m = 0; m < 4; ++m) _Pragma("unroll") for (int n = 0; n < 2; ++n) _Pragma("unroll") for (int k = 0; k < 2; ++k) \
        acc[ai][bj][m][n] = __builtin_amdgcn_mfma_f32_16x16x32_bf16(Bt[n][k], At[m][k], acc[ai][bj][m][n], 0, 0, 0); __builtin_amdgcn_s_setprio(0); } while (0)
#define PG8_WAIT_V(n) asm volatile("s_waitcnt vmcnt(" #n ")" ::: "memory")
#define PG8_WAIT_L(n) asm volatile("s_waitcnt lgkmcnt(" #n ")" ::: "memory")
#define PG8_BAR __builtin_amdgcn_s_barrier()
#define PG8_SCHED __builtin_amdgcn_sched_barrier(0)
    Unit cur, nxt; int ui = 0;
    if (!S.next(0, cur)) return;
    f32x4 acc[2][2][4][2];
#pragma unroll
    for (int a = 0; a < 2; ++a)
#pragma unroll
        for (int b = 0; b < 2; ++b)
#pragma unroll
            for (int m = 0; m < 4; ++m)
#pragma unroll
                for (int n = 0; n < 2; ++n) acc[a][b][m][n] = (f32x4){0.f, 0.f, 0.f, 0.f};
    bf16x8 At[4][2], B0[2][2], B1[2][2];
    const char* cA = (const char*)g.A + (size_t)cur.pm * tstep; const char* cB = (const char*)g.Bt + (size_t)cur.pn * tstep;
    S.a_ready(cur);
    if constexpr (SP2) {
        PG8_STAGE(PG8_SB(0, 0), cB, voffB); PG8_STAGE(PG8_SB(0, 1), cB + hstep, voffB); PG8_STAGE(PG8_SA(0, 0), cA, voffA); PG8_STAGE(PG8_SA(0, 1), cA + hstep, voffA);
        if (wr == 1) PG8_BAR;
        PG8_WAIT_V(2); PG8_BAR;
        PG8_STAGE(PG8_SB(1, 0), cB + kstep, voffB); PG8_STAGE(PG8_SA(1, 0), cA + kstep, voffA); PG8_STAGE(PG8_SB(1, 1), cB + hstep + kstep, voffB);
        PG8_WAIT_V(6); PG8_BAR;
    } else {
        PG8_STAGE(PG8_SB(0, 0), cB, voffB); PG8_STAGE(PG8_SA(0, 0), cA, voffA); PG8_STAGE(PG8_SB(0, 1), cB + hstep, voffB); PG8_STAGE(PG8_SA(0, 1), cA + hstep, voffA);
        if (wr == 1) PG8_BAR;
        PG8_WAIT_V(4); PG8_BAR;
        PG8_STAGE(PG8_SB(1, 0), cB + kstep, voffB); PG8_STAGE(PG8_SA(1, 0), cA + kstep, voffA); PG8_STAGE(PG8_SB(1, 1), cB + hstep + kstep, voffB);
        PG8_WAIT_V(6); PG8_BAR;
    }
    for (;;) {
        const bool has_next = S.next(ui + 1, nxt);
        const char* nA = has_next ? (const char*)g.A + (size_t)nxt.pm * tstep : cA; const char* nB = has_next ? (const char*)g.Bt + (size_t)nxt.pn * tstep : cB;
        for (int t = 0; t < nt; t += 2) {
            const bool last = (t == nt - 2);
            const char* a1 = cA + (size_t)(t + 1) * kstep;
            const char* a2 = last ? nA : cA + (size_t)(t + 2) * kstep; const char* b2 = last ? nB : cB + (size_t)(t + 2) * kstep;
            const char* a3 = a2 + kstep; const char* b3 = b2 + kstep;
            if (last && has_next) S.a_ready(nxt);
            if constexpr (SP2) {
            PG8_LDB(B0, 0, 0); PG8_LDB(B1, 0, 1); PG8_SCHED; PG8_LDA(At, 0, 0); PG8_STAGE(PG8_SA(1, 1), a1 + hstep, voffA);
            PG8_WAIT_V(8); PG8_WAIT_L(0); PG8_BAR; PG8_MMA(0, 0, At, B0); PG8_MMA(0, 1, At, B1); PG8_BAR; PG8_SCHED;
            PG8_LDA(At, 0, 1); PG8_STAGE(PG8_SB(0, 0), b2, voffB); PG8_STAGE(PG8_SB(0, 1), b2 + hstep, voffB); PG8_STAGE(PG8_SA(0, 0), a2, voffA);
            PG8_WAIT_V(8); PG8_WAIT_L(0); PG8_BAR; PG8_MMA(1, 0, At, B0); PG8_MMA(1, 1, At, B1); PG8_BAR; PG8_SCHED;
            PG8_LDB(B0, 1, 0); PG8_LDB(B1, 1, 1); PG8_SCHED; PG8_LDA(At, 1, 0); PG8_STAGE(PG8_SA(0, 1), a2 + hstep, voffA);
            PG8_WAIT_V(8); PG8_WAIT_L(0); PG8_BAR; PG8_MMA(0, 0, At, B0); PG8_MMA(0, 1, At, B1); PG8_BAR; PG8_SCHED;
            PG8_LDA(At, 1, 1); PG8_STAGE(PG8_SB(1, 0), b3, voffB); PG8_STAGE(PG8_SB(1, 1), b3 + hstep, voffB); PG8_STAGE(PG8_SA(1, 0), a3, voffA);
            PG8_WAIT_V(8); PG8_WAIT_L(0); PG8_BAR; PG8_MMA(1, 0, At, B0); PG8_MMA(1, 1, At, B1); PG8_BAR; PG8_SCHED;
            } else {
            PG8_LDB(B0, 0, 0); PG8_SCHED; PG8_LDA(At, 0, 0); PG8_STAGE(PG8_SA(1, 1), a1 + hstep, voffA);
            PG8_WAIT_L(8); PG8_BAR; PG8_WAIT_L(0); PG8_MMA(0, 0, At, B0); PG8_BAR; PG8_SCHED;
            PG8_LDB(B1, 0, 1); PG8_STAGE(PG8_SB(0, 0), b2, voffB);
            PG8_BAR; PG8_WAIT_L(0); PG8_MMA(0, 1, At, B1); PG8_BAR;
            PG8_LDA(At, 0, 1); PG8_STAGE(PG8_SA(0, 0), a2, voffA);
            PG8_BAR; PG8_WAIT_L(0); PG8_MMA(1, 0, At, B0); PG8_BAR; PG8_SCHED;
            PG8_STAGE(PG8_SB(0, 1), b2 + hstep, voffB);
            PG8_WAIT_V(6); PG8_BAR; PG8_MMA(1, 1, At, B1); PG8_BAR;
            PG8_LDB(B0, 1, 0); PG8_SCHED; PG8_LDA(At, 1, 0); PG8_STAGE(PG8_SA(0, 1), a2 + hstep, voffA);
            PG8_WAIT_L(8); PG8_BAR; PG8_WAIT_L(0); PG8_MMA(0, 0, At, B0); PG8_BAR; PG8_SCHED;
            PG8_LDB(B1, 1, 1); PG8_STAGE(PG8_SB(1, 0), b3, voffB);
            PG8_BAR; PG8_WAIT_L(0); PG8_MMA(0, 1, At, B1); PG8_BAR;
            PG8_LDA(At, 1, 1); PG8_STAGE(PG8_SA(1, 0), a3, voffA);
            PG8_BAR; PG8_WAIT_L(0); PG8_MMA(1, 0, At, B0); PG8_BAR; PG8_SCHED;
            PG8_STAGE(PG8_SB(1, 1), b3 + hstep, voffB);
            PG8_WAIT_V(6); PG8_BAR; PG8_MMA(1, 1, At, B1); PG8_BAR;
            }
        }
        if constexpr (ALIGN_EPI) { if (wr == 0) PG8_BAR; }
        if constexpr (!Epi::AFTER_DRAIN) { E(acc, cur, wr, wc, fr, fq); S.done(cur); }
        if (!has_next) break;
#pragma unroll
        for (int a = 0; a < 2; ++a)
#pragma unroll
            for (int b = 0; b < 2; ++b)
#pragma unroll
                for (int m = 0; m < 4; ++m)
#pragma unroll
                    for (int n = 0; n < 2; ++n) acc[a][b][m][n] = (f32x4){0.f, 0.f, 0.f, 0.f};
        cur = nxt; cA = nA; cB = nB; ++ui;
        if constexpr (ALIGN_EPI) { if (wr == 1) PG8_BAR; }
    }
    PG8_WAIT_V(0);
    if constexpr (!ALIGN_EPI) { if (wr == 0) PG8_BAR; }
    PG8_BAR;
    if constexpr (Epi::AFTER_DRAIN) { E.fused(acc, cur, wr, wc, fr, fq, lds, wid, lane); S.done(cur); }
#undef PG8_SA
#undef PG8_SB
#undef PG8_STAGE
#undef PG8_LDA
#undef PG8_LDB
#undef PG8_MMA
#undef PG8_WAIT_V
#undef PG8_WAIT_L
#undef PG8_BAR
#undef PG8_SCHED
}
}

#define LAS __attribute__((address_space(3)))
#define CAS __attribute__((address_space(4)))
#define GAS __attribute__((address_space(1)))
typedef unsigned short bf16;
typedef float f32x4 __attribute__((ext_vector_type(4)));
typedef float f32x2 __attribute__((ext_vector_type(2)));
typedef float f32x16 __attribute__((ext_vector_type(16)));
typedef short bf16x8 __attribute__((ext_vector_type(8)));
typedef short s16x4 __attribute__((ext_vector_type(4)));
typedef unsigned u32x4 __attribute__((ext_vector_type(4)));
typedef unsigned u32x2 __attribute__((ext_vector_type(2)));
typedef __bf16 bf16x2_t __attribute__((ext_vector_type(2)));

constexpr int M = 16384, D = 2048, T = 4096, NB = 4, DFF = 5632, DPLE = 256;
constexpr int NIN0 = 6400, NZ = 3328, DH = 1024;
constexpr int NTHREADS = 512, NWAVES = 8;
constexpr float RMS_EPS = 1e-6f;
constexpr int SEGT = 512, NSEG = T / SEGT;
constexpr int REC = 512;

constexpr size_t SZ_WGU = (size_t)2 * DFF * D * 2, SZ_WD = (size_t)D * DFF * 2, SZ_WPG = (size_t)D * D * 2, SZ_WPP = (size_t)D * DPLE * 2;
constexpr size_t OFF_WGU1 = 0;
constexpr size_t OFF_WD1 = OFF_WGU1 + 2 * SZ_WGU;
constexpr size_t OFF_WGU2 = OFF_WD1 + 2 * SZ_WD;
constexpr size_t OFF_WD2 = OFF_WGU2 + 2 * SZ_WGU;
constexpr size_t OFF_WPG = OFF_WD2 + 2 * SZ_WD;
constexpr size_t OFF_WPP = OFF_WPG + 2 * SZ_WPG;
constexpr size_t OFF_WIN0 = OFF_WPP + 2 * SZ_WPP;
constexpr size_t OFF_WOUT0 = OFF_WIN0 + (size_t)NIN0 * D * 2;
constexpr size_t OFF_WSIN = OFF_WOUT0 + (size_t)D * D * 2;
constexpr size_t OFF_WSOUT = OFF_WSIN + (size_t)DH * D * 2;
constexpr size_t OFF_HB = OFF_WSOUT + (size_t)2 * D * DH * 2;
constexpr size_t OFF_PB = OFF_HB + (size_t)M * D * 2;
constexpr size_t OFF_SS = OFF_PB + (size_t)2 * M * DPLE * 2;
constexpr size_t OFF_R = OFF_SS + (size_t)8 * M * 4;
constexpr size_t OFF_QB = OFF_R, OFF_KB = OFF_QB + (size_t)M * DH * 2, OFF_VT = OFF_KB + (size_t)M * DH * 2, OFF_Z = OFF_VT + (size_t)M * DH * 2;
constexpr size_t OFF_U = OFF_R, OFF_YS = OFF_U + (size_t)M * DH * 2;
constexpr size_t SZ_R = (size_t)3 * M * DH * 2 + (size_t)M * NZ * 2;
static_assert(SZ_R >= (size_t)M * DFF * 2, "ACT fits the aliased region");
constexpr size_t OFF_MIX = OFF_R + SZ_R;
constexpr size_t OFF_SCAN = OFF_MIX + (size_t)M * D * 2;
constexpr size_t SZ_SCANSEG = (size_t)NB * 16 * SEGT * 384 * 4;
constexpr size_t OFF_BAR = OFF_SCAN + 2 * SZ_SCANSEG;
constexpr size_t BAR_BYTES = 16384;
constexpr size_t WS_END = OFF_BAR + BAR_BYTES;
static_assert(WS_END <= (size_t)840 * 1000 * 1000, "workspace budget"); static_assert(2 * SZ_SCANSEG >= (size_t)M * D * 2, "HB2 fits the scan buffers");

constexpr int LDS_BYTES = 147456;

struct Params { const float* in[40]; float* out; unsigned char* ws; };
__device__ __forceinline__ const float* inp(int i) { int k = i; asm volatile("" : "+s"(k)); return (const float*)(const GAS float*)(((const float* const CAS*)__builtin_amdgcn_kernarg_segment_ptr())[k]); }

__device__ __forceinline__ unsigned cvtpk(float lo, float hi) { f32x2 v = {lo, hi}; bf16x2_t b = __builtin_convertvector(v, bf16x2_t); return __builtin_bit_cast(unsigned, b); }
__device__ __forceinline__ float bf2f(unsigned short b) { return __builtin_bit_cast(float, (unsigned)b << 16); }
__device__ __forceinline__ float bflo(unsigned u) { return __builtin_bit_cast(float, u << 16); }
__device__ __forceinline__ float bfhi(unsigned u) { return __builtin_bit_cast(float, u & 0xffff0000u); }
__device__ __forceinline__ float wave_sum(float v) {
#pragma unroll
    for (int o = 1; o < 64; o <<= 1) v += __shfl_xor(v, o);
    return v;
}
__device__ __forceinline__ float fast_sigmoid(float x) { return __builtin_amdgcn_rcpf(1.0f + __expf(-x)); }

struct ConvJob { const float* W; const float* gain; bf16* WT; int K, nblk, ldw, mode, off; };
__device__ __forceinline__ void conv_item(const float* W, const float* gain, bf16* WT, int K, int nblk, int ldw, int mode, int off, LAS float* scr, int item, int lane) {
    const int kb = item / nblk, nb = item % nblk, k0 = 64 * kb, n0 = 32 * nb;
    float wv_[32];
#pragma unroll
    for (int i = 0; i < 32; ++i) wv_[i] = W[(size_t)(k0 + 2 * i + (lane >> 5)) * ldw + n0 + (lane & 31)];
    if (gain) {
#pragma unroll
        for (int i = 0; i < 32; ++i) wv_[i] *= gain[k0 + 2 * i + (lane >> 5)];
    }
#pragma unroll
    for (int i = 0; i < 32; ++i) scr[(2 * i + (lane >> 5)) * 33 + (lane & 31)] = wv_[i];
    asm volatile("s_waitcnt lgkmcnt(0)" ::: "memory");
    const int c = lane & 7;
    const int drow0 = mode ? ((n0 >> 7) * 256 + (n0 & 127) + off) : (n0 + off);
#pragma unroll
    for (int j = 0; j < 4; ++j) { const int n = (lane >> 3) + 8 * j; const LAS float* s = scr + (8 * c) * 33 + n;
        u32x4 o; o.x = cvtpk(s[0 * 33], s[1 * 33]); o.y = cvtpk(s[2 * 33], s[3 * 33]); o.z = cvtpk(s[4 * 33], s[5 * 33]); o.w = cvtpk(s[6 * 33], s[7 * 33]);
        *(u32x4*)(WT + (size_t)(drow0 + n) * K + k0 + 8 * c) = o; }
    asm volatile("s_waitcnt lgkmcnt(0)" ::: "memory");
}
constexpr int I_GU = (D / 64) * (DFF / 32), I_DN = (DFF / 64) * (D / 32), I_PG = (D / 64) * (D / 32), I_PP = (DPLE / 64) * (D / 32);
constexpr int I_LAYER = 4 * I_GU + 2 * I_DN + I_PG + I_PP;
constexpr int I_IN0 = (D / 64) * (NIN0 / 32), I_OUT0 = I_PG, I_SIN = (D / 64) * (DH / 32), I_SOUT = (DH / 64) * (D / 32);
constexpr int I_TOTAL = 2 * I_LAYER + I_IN0 + I_OUT0 + I_SIN + 2 * I_SOUT;

__device__ __forceinline__ void p0_prologue(unsigned char* ws, LAS unsigned char* lds, int gw, int NGW, int wave, int lane) {
    LAS float* scr = (LAS float*)(lds + wave * 16384);
    for (int it0 = gw; it0 < I_TOTAL; it0 += NGW) {
        int it = it0;
        const float* W; const float* gain = nullptr; bf16* WT; int K, N, ldw, mode = 0, off = 0;
        if (it < 2 * I_LAYER) {
            const int l = it >= I_LAYER; it -= l * I_LAYER;
            const size_t wo = (size_t)l * D * DFF;
            if (it < 2 * I_GU) { const int up = it >= I_GU; it -= up * I_GU; W = (up ? inp(4) : inp(3)) + wo; gain = inp(2) + l * D; WT = (bf16*)(ws + OFF_WGU1 + l * SZ_WGU); K = D; N = DFF; ldw = DFF; mode = 1; off = up * 128; }
            else if (it < 2 * I_GU + I_DN) { it -= 2 * I_GU; W = inp(5) + wo; WT = (bf16*)(ws + OFF_WD1 + l * SZ_WD); K = DFF; N = D; ldw = D; }
            else if (it < 4 * I_GU + I_DN) { it -= 2 * I_GU + I_DN; const int up = it >= I_GU; it -= up * I_GU; W = (up ? inp(9) : inp(8)) + wo; gain = inp(7) + l * D; WT = (bf16*)(ws + OFF_WGU2 + l * SZ_WGU); K = D; N = DFF; ldw = DFF; mode = 1; off = up * 128; }
            else if (it < 4 * I_GU + 2 * I_DN) { it -= 4 * I_GU + I_DN; W = inp(10) + wo; WT = (bf16*)(ws + OFF_WD2 + l * SZ_WD); K = DFF; N = D; ldw = D; }
            else if (it < 4 * I_GU + 2 * I_DN + I_PG) { it -= 4 * I_GU + 2 * I_DN; W = inp(12) + (size_t)l * D * D; gain = inp(11) + l * D; WT = (bf16*)(ws + OFF_WPG + l * SZ_WPG); K = D; N = D; ldw = D; }
            else { it -= 4 * I_GU + 2 * I_DN + I_PG; W = inp(13) + (size_t)l * DPLE * D; WT = (bf16*)(ws + OFF_WPP + l * SZ_WPP); K = DPLE; N = D; ldw = D; }
        } else {
            it -= 2 * I_LAYER;
            if (it < I_IN0) { W = inp(14); gain = inp(6); WT = (bf16*)(ws + OFF_WIN0); K = D; N = NIN0; ldw = NIN0; }
            else if (it < I_IN0 + I_OUT0) { it -= I_IN0; W = inp(29); WT = (bf16*)(ws + OFF_WOUT0); K = D; N = D; ldw = D; }
            else if (it < I_IN0 + I_OUT0 + I_SIN) { it -= I_IN0 + I_OUT0; W = inp(30); gain = inp(6) + D; WT = (bf16*)(ws + OFF_WSIN); K = D; N = DH; ldw = DH; }
            else { it -= I_IN0 + I_OUT0 + I_SIN; const int gt = it >= I_SOUT; it -= gt * I_SOUT; W = inp(39) + gt * D; WT = (bf16*)(ws + OFF_WSOUT); K = DH; N = D; ldw = 2 * D; mode = 1; off = gt * 128; }
        }
        conv_item(W, gain, WT, K, N / 32, ldw, mode, off, scr, it, lane);
    }
    bf16* hb = (bf16*)(ws + OFF_HB); float* ss = (float*)(ws + OFF_SS); bf16* pb = (bf16*)(ws + OFF_PB);
    const float* x = inp(0); const float* p = inp(1);
    for (int m = gw; m < M; m += NGW) {
        const f32x4* xr = (const f32x4*)(x + (size_t)m * D) + lane; float s = 0.f;
        u32x2* o = (u32x2*)(hb + (size_t)m * D) + lane;
#pragma unroll
        for (int j = 0; j < 8; ++j) { const f32x4 v = xr[64 * j]; s += (v.x * v.x + v.y * v.y) + (v.z * v.z + v.w * v.w); u32x2 w; w.x = cvtpk(v.x, v.y); w.y = cvtpk(v.z, v.w); o[64 * j] = w; }
        s = wave_sum(s);
        if (lane < 8) ss[(size_t)lane * M + m] = (lane == 0) ? s : 0.f;
    }
    for (int m = gw; m < 2 * M; m += NGW) {
        const f32x4 v = ((const f32x4*)(p + (size_t)m * DPLE))[lane]; u32x2 w; w.x = cvtpk(v.x, v.y); w.y = cvtpk(v.z, v.w);
        ((u32x2*)(pb + (size_t)m * DPLE))[lane] = w;
    }
}

using pg8::Unit;
struct EpiSwiGLU {
    static constexpr bool PERM = true, AFTER_DRAIN = false;
    bf16* ACT; const float* ss;
    __device__ __forceinline__ void operator()(const f32x4 (&acc)[2][2][4][2], const Unit& u, int wr, int wc, int fr, int fq) const {
        const int row0 = u.pm * 256 + wr * 64 + fr, col0 = u.pn * 128 + wc * 32 + 8 * fq;
#pragma unroll
        for (int ai = 0; ai < 2; ++ai)
#pragma unroll
            for (int m = 0; m < 4; ++m) {
                const int row = row0 + ai * 128 + m * 16;
                const float r = __builtin_amdgcn_rsqf(ss[row] * (1.0f / D) + RMS_EPS);
                float o[8];
#pragma unroll
                for (int n = 0; n < 2; ++n)
#pragma unroll
                    for (int j = 0; j < 4; ++j) { const float g = acc[ai][0][m][n][j] * r, uu = acc[ai][1][m][n][j] * r; o[4 * n + j] = g * fast_sigmoid(g) * uu; }
                u32x4 w; w.x = cvtpk(o[0], o[1]); w.y = cvtpk(o[2], o[3]); w.z = cvtpk(o[4], o[5]); w.w = cvtpk(o[6], o[7]);
                *(u32x4*)(ACT + (size_t)row * DFF + col0) = w;
            }
    }
};
template <int MODE> struct EpiRes {
    static constexpr bool PERM = true, AFTER_DRAIN = false;
    const float* hin; float* hout; bf16* hb; float* ssn; float scale; const float* ssc; const bf16* pp;
    __device__ __forceinline__ void operator()(const f32x4 (&acc)[2][2][4][2], const Unit& u, int wr, int wc, int fr, int fq) const {
        const int row0 = u.pm * 256 + wr * 64 + fr;
#pragma unroll
        for (int ai = 0; ai < 2; ++ai)
#pragma unroll
            for (int m = 0; m < 4; ++m) {
                const int row = row0 + ai * 128 + m * 16;
                float r = 1.f; if (MODE == 2) r = __builtin_amdgcn_rsqf(ssc[row] * (1.0f / D) + RMS_EPS);
                float sq = 0.f;
#pragma unroll
                for (int bj = 0; bj < (MODE == 1 ? 1 : 2); ++bj) {
                    const int col = (MODE == 1) ? (u.pn * 128 + wc * 32 + 8 * fq) : (u.pn * 256 + bj * 128 + wc * 32 + 8 * fq);
                    const size_t idx = (size_t)row * D + col;
                    f32x4 h0 = *(const f32x4*)(hin + idx), h1 = *(const f32x4*)(hin + idx + 4);
                    f32x4 v0, v1;
                    if (MODE == 0) { v0 = acc[ai][bj][m][0] * scale; v1 = acc[ai][bj][m][1] * scale; }
                    else if (MODE == 1) {
#pragma unroll
                        for (int j = 0; j < 4; ++j) { v0[j] = acc[ai][0][m][0][j] * fast_sigmoid(acc[ai][1][m][0][j]); v1[j] = acc[ai][0][m][1][j] * fast_sigmoid(acc[ai][1][m][1][j]); }
                    } else {
                        const u32x4 pw = *(const u32x4*)(pp + idx);
                        const float pv[8] = {bflo(pw.x), bfhi(pw.x), bflo(pw.y), bfhi(pw.y), bflo(pw.z), bfhi(pw.z), bflo(pw.w), bfhi(pw.w)};
#pragma unroll
                        for (int j = 0; j < 4; ++j) { v0[j] = fast_sigmoid(acc[ai][bj][m][0][j] * r) * pv[j]; v1[j] = fast_sigmoid(acc[ai][bj][m][1][j] * r) * pv[4 + j]; }
                    }
                    h0 += v0; h1 += v1;
                    *(f32x4*)(hout + idx) = h0; *(f32x4*)(hout + idx + 4) = h1;
                    u32x4 w; w.x = cvtpk(h0[0], h0[1]); w.y = cvtpk(h0[2], h0[3]); w.z = cvtpk(h1[0], h1[1]); w.w = cvtpk(h1[2], h1[3]);
                    if (hb) *(u32x4*)(hb + idx) = w;
                    sq += (h0[0] * h0[0] + h0[1] * h0[1]) + (h0[2] * h0[2] + h0[3] * h0[3]) + (h1[0] * h1[0] + h1[1] * h1[1]) + (h1[2] * h1[2] + h1[3] * h1[3]);
                }
                sq += __shfl_xor(sq, 16); sq += __shfl_xor(sq, 32);
                if (fq == 0 && ssn) atomicAdd(ssn + row, sq);
            }
    }
};
template <bool LAYER0> struct EpiStore {
    static constexpr bool PERM = true, AFTER_DRAIN = false;
    const float* ss; bf16* O; int ldo; bf16 *QB, *KB, *VT, *Z;
    __device__ __forceinline__ void operator()(const f32x4 (&acc)[2][2][4][2], const Unit& u, int wr, int wc, int fr, int fq) const {
        const int row0 = u.pm * 256 + wr * 64 + fr;
#pragma unroll
        for (int ai = 0; ai < 2; ++ai)
#pragma unroll
            for (int m = 0; m < 4; ++m) {
                const int row = row0 + ai * 128 + m * 16;
                const float r = ss ? __builtin_amdgcn_rsqf(ss[row] * (1.0f / D) + RMS_EPS) : 1.f;
#pragma unroll
                for (int bj = 0; bj < 2; ++bj) {
                    const f32x4 v0 = acc[ai][bj][m][0] * r, v1 = acc[ai][bj][m][1] * r;
                    const int cl = bj * 128 + wc * 32 + 8 * fq;
                    if (LAYER0 && u.pn >= 8 && u.pn < 12) {
                        const int b = row >> 12, t = row & 4095, ch = (u.pn - 8) * 256 + cl;
                        bf16* vp = VT + ((size_t)(b * DH + ch)) * T + t;
                        const float vals[8] = {v0[0], v0[1], v0[2], v0[3], v1[0], v1[1], v1[2], v1[3]};
                        const bool oddl = (fr & 1) != 0;
#pragma unroll
                        for (int q = 0; q < 4; ++q) {
                            const float mine = oddl ? vals[2 * q + 1] : vals[2 * q], send = oddl ? vals[2 * q] : vals[2 * q + 1];
                            const float recv = __builtin_bit_cast(float, __builtin_amdgcn_mov_dpp(__builtin_bit_cast(int, send), 0xB1, 0xF, 0xF, true));
                            bf16* dst = vp + (size_t)(2 * q + (oddl ? 1 : 0)) * T - (oddl ? 1 : 0);
                            *(unsigned*)dst = oddl ? cvtpk(recv, mine) : cvtpk(mine, recv);
                        }
                    } else {
                        bf16* dst;
                        if (LAYER0) {
                            if (u.pn < 4) dst = QB + (size_t)row * DH + u.pn * 256 + cl;
                            else if (u.pn < 8) dst = KB + (size_t)row * DH + (u.pn - 4) * 256 + cl;
                            else dst = Z + (size_t)row * NZ + (u.pn - 12) * 256 + cl;
                        } else dst = O + (size_t)row * ldo + u.pn * 256 + cl;
                        u32x4 w; w.x = cvtpk(v0[0], v0[1]); w.y = cvtpk(v0[2], v0[3]); w.z = cvtpk(v1[0], v1[1]); w.w = cvtpk(v1[2], v1[3]);
                        *(u32x4*)dst = w;
                    }
                }
            }
    }
};
__device__ __forceinline__ int opq(int v) { asm volatile("" : "+s"(v)); return v; }
__device__ __forceinline__ int opqv(int v) { asm volatile("" : "+v"(v)); return v; }
__device__ __forceinline__ unsigned char* wsp(unsigned char* ws, size_t off) { asm volatile("" : "+s"(ws)); return (unsigned char*)((GAS unsigned char*)ws + off); }
#define GEMM_PHASE(EPI, Aptr, Bptr, NN, KK, Eobj) do { pg8::Gemm g_{(const pg8::bf16_t*)(Aptr), (const pg8::bf16_t*)(Bptr), M, (NN), (KK)}; pg8::StaticOrder S_; S_.init(M, (NN), opq((int)gridDim.x), opq((int)blockIdx.x)); \
        pg8::gemm_phase<EPI, pg8::StaticOrder, true, true>(lds, g_, S_, (Eobj)); } while (0)

#define XB_TMO      128
#define XB_XCNT(j)  (256  + 64 * (j))
#define XB_XSUB(j)  (1280 + 64 * (j))
#define XB_XGEN(j)  (2304 + 64 * (j))
#define XB_TOP      3328
#define XB_TOPGEN   3392
#define XCD_BAR_WORDS 3456
#define XB_SPIN_CAP (1u << 18)

__device__ __forceinline__ unsigned xb_ld(unsigned* p)              { return __hip_atomic_load(p, __ATOMIC_RELAXED, __HIP_MEMORY_SCOPE_AGENT); }
__device__ __forceinline__ unsigned xb_add(unsigned* p, unsigned v) { return __hip_atomic_fetch_add(p, v, __ATOMIC_RELAXED, __HIP_MEMORY_SCOPE_AGENT); }
__device__ __forceinline__ unsigned xb_xcc_id() { return (unsigned)__builtin_amdgcn_s_getreg((3 << 11) | 20) & 0xFu; }
#define XB_SPIN(cond, bar) do { unsigned _sp = 0; while (cond) { __builtin_amdgcn_s_sleep(1); \
    if ((++_sp & 255u) == 0u) { if (xb_ld(&(bar)[XB_TMO])) break; if (_sp > XB_SPIN_CAP) { atomicAdd(&(bar)[XB_TMO], 1u); break; } } } } while (0)

struct XcdBarrier {
    unsigned* bar; unsigned x;
    volatile LAS unsigned* st;
};

__device__ __forceinline__ XcdBarrier xcd_barrier_post(unsigned* bar, volatile LAS unsigned* st) {
    XcdBarrier b; b.bar = bar; b.x = xb_xcc_id(); b.st = st;
    if (threadIdx.x == 0) (void)xb_add(&bar[XB_XCNT(b.x)], 1u);
    return b;
}
__device__ __forceinline__ void xcd_barrier_complete(unsigned* bar, unsigned x, unsigned& nloc, unsigned& nx) {
    const unsigned G = gridDim.x * gridDim.y * gridDim.z;
    unsigned sum, cnt, mine, sp = 0u;
    for (;;) {
        sum = 0u; cnt = 0u; mine = 0u;
#pragma unroll
        for (unsigned j = 0; j < 16; ++j) { const unsigned c = xb_ld(&bar[XB_XCNT(j)]); sum += c; cnt += (c > 0u) ? 1u : 0u; mine = (j == x) ? c : mine; }
        if (sum == G) break;
        __builtin_amdgcn_s_sleep(1);
        if ((++sp & 255u) == 0u) { if (xb_ld(&bar[XB_TMO])) break; if (sp > XB_SPIN_CAP) { atomicAdd(&bar[XB_TMO], 1u); break; } }
    }
    nloc = mine > 0u ? mine : 1u; nx = cnt > 0u ? cnt : 1u;
}

__device__ __forceinline__ void xcd_barrier(const XcdBarrier& b) {
    asm volatile("s_waitcnt vmcnt(0)" ::: "memory");
    __syncthreads();
    if (threadIdx.x == 0) {
        unsigned* bar = b.bar;
        __builtin_amdgcn_s_waitcnt(0);
        unsigned nloc = b.st[0], nx = b.st[1];
        if (nloc == 0u) { xcd_barrier_complete(bar, b.x, nloc, nx); b.st[0] = nloc; b.st[1] = nx; }
        const unsigned old = xb_add(&bar[XB_XSUB(b.x)], 1u);
        const unsigned gen = old / nloc;
        if (old + 1u == (gen + 1u) * nloc) {
            __builtin_amdgcn_fence(__ATOMIC_RELEASE, "agent");
            asm volatile("s_waitcnt vmcnt(0)" ::: "memory");
            const unsigned og = xb_add(&bar[XB_TOP], 1u);
            const unsigned tg = og / nx;
            if (og + 1u == (tg + 1u) * nx) xb_add(&bar[XB_TOPGEN], 1u);
            else XB_SPIN(xb_ld(&bar[XB_TOPGEN]) == tg, bar);
            __builtin_amdgcn_fence(__ATOMIC_ACQUIRE, "agent");
            xb_add(&bar[XB_XGEN(b.x)], 1u);
            asm volatile("s_waitcnt vmcnt(0)" ::: "memory");
        } else {
            XB_SPIN(xb_ld(&bar[XB_XGEN(b.x)]) == gen, bar);
            __builtin_amdgcn_fence(__ATOMIC_ACQUIRE, "agent");
            asm volatile("s_waitcnt vmcnt(0)" ::: "memory");
        }
    }
    __syncthreads();
}


constexpr size_t OFF_YRAW = OFF_QB;
constexpr size_t OFF_GG = OFF_VT;
constexpr size_t OFF_BV = OFF_HB;
constexpr int RECF = 384;
static_assert((size_t)NB * 16 * SEGT * RECF * 4 <= SZ_SCANSEG, "segment buffers fit");

__device__ __forceinline__ float quad_sum(float v) {
    v += __builtin_bit_cast(float, __builtin_amdgcn_mov_dpp(__builtin_bit_cast(int, v), 0xB1, 0xF, 0xF, true));
    v += __builtin_bit_cast(float, __builtin_amdgcn_mov_dpp(__builtin_bit_cast(int, v), 0x4E, 0xF, 0xF, true));
    return v;
}
__device__ __forceinline__ void unpack8(const u32x4 w, float* x) { x[0] = bflo(w.x); x[1] = bfhi(w.x); x[2] = bflo(w.y); x[3] = bfhi(w.y); x[4] = bflo(w.z); x[5] = bfhi(w.z); x[6] = bflo(w.w); x[7] = bfhi(w.w); }

__device__ __forceinline__ void qknorm_rows(bf16* QBp, bf16* KBp, int gw, int NGW, int lane) {
    const float* qg = inp(15); const float* kg = inp(16);
    const int d0 = (lane & 3) * 16;
    float gq[16], gk[16];
#pragma unroll
    for (int i = 0; i < 16; ++i) { gq[i] = qg[d0 + i] * 0.125f; gk[i] = kg[d0 + i]; }
    for (int it = gw; it < 2 * M; it += NGW) {
        const bool isk = it >= M; const int row = isk ? it - M : it;
        bf16* p = (isk ? KBp : QBp) + (size_t)row * DH + lane * 16;
        float x[16]; unpack8(*(const u32x4*)p, x); unpack8(*(const u32x4*)(p + 8), x + 8);
        float s = 0.f;
#pragma unroll
        for (int i = 0; i < 16; ++i) s += x[i] * x[i];
        s = quad_sum(s);
        const float rs = __builtin_amdgcn_rsqf(s * (1.0f / 64.0f) + RMS_EPS);
#pragma unroll
        for (int i = 0; i < 16; ++i) x[i] = x[i] * rs * (isk ? gk[i] : gq[i]);
        u32x4 a, b2; a.x = cvtpk(x[0], x[1]); a.y = cvtpk(x[2], x[3]); a.z = cvtpk(x[4], x[5]); a.w = cvtpk(x[6], x[7]);
        b2.x = cvtpk(x[8], x[9]); b2.y = cvtpk(x[10], x[11]); b2.z = cvtpk(x[12], x[13]); b2.w = cvtpk(x[14], x[15]);
        *(u32x4*)p = a; *(u32x4*)(p + 8) = b2;
    }
}

#define MFMA32(a, b, c) __builtin_amdgcn_mfma_f32_32x32x16_bf16((a), (b), (c), 0, 0, 0)
__device__ __forceinline__ int crow(int i, int hh) { return (i & 3) + 8 * (i >> 2) + 4 * hh; }
__device__ __forceinline__ void attn_unit(const bf16* QBp, const bf16* KBp, const bf16* VTp, bf16* MIXp, const float* biasg, int unit, int lane) {
    const int h = unit & 15, c = (unit >> 4) & 63, b = unit >> 10;
    const int r = lane & 31, hh = lane >> 5;
    const float* bias = biasg + h * 192;
    const size_t rowq0 = (size_t)b * T + c * 64;
    bf16x8 qf[2][4];
#pragma unroll
    for (int qt = 0; qt < 2; ++qt)
#pragma unroll
        for (int s = 0; s < 4; ++s) qf[qt][s] = *(const bf16x8*)(QBp + (rowq0 + 32 * qt + r) * DH + h * 64 + 16 * s + 8 * hh);
    f32x16 oacc[2][2];
#pragma unroll
    for (int a = 0; a < 2; ++a)
#pragma unroll
        for (int q = 0; q < 2; ++q)
#pragma unroll
            for (int i = 0; i < 16; ++i) oacc[a][q][i] = 0.f;
    float mrun[2] = {-1e30f, -1e30f}, lrun[2] = {0.f, 0.f};
    const float bconst = bias[191];
    for (int kc = (c < 8 ? 8 - c : 0); kc <= 8; ++kc) {
        const int kch = c - 8 + kc;
        for (int kt = 0; kt < 2; ++kt) {
            const size_t krow = (size_t)b * T + kch * 64 + kt * 32 + r;
            bf16x8 kf[4];
#pragma unroll
            for (int s = 0; s < 4; ++s) kf[s] = *(const bf16x8*)(KBp + krow * DH + h * 64 + 16 * s + 8 * hh);
            bf16x8 vf[2][2];
#pragma unroll
            for (int dt = 0; dt < 2; ++dt)
#pragma unroll
                for (int s2 = 0; s2 < 2; ++s2) {
                    const bf16* vp = VTp + ((size_t)(b * DH + h * 64 + 32 * dt + r)) * T + kch * 64 + kt * 32 + 16 * s2 + 4 * hh;
                    const s16x4 lo = *(const s16x4*)vp, hi = *(const s16x4*)(vp + 8);
                    vf[dt][s2] = (bf16x8){lo[0], lo[1], lo[2], lo[3], hi[0], hi[1], hi[2], hi[3]};
                }
#pragma unroll
            for (int qt = 0; qt < 2; ++qt) {
                f32x16 st;
#pragma unroll
                for (int i = 0; i < 16; ++i) st[i] = 0.f;
#pragma unroll
                for (int s = 0; s < 4; ++s) st = MFMA32(kf[s], qf[qt][s], st);
                if (kc <= 5) {
#pragma unroll
                    for (int i = 0; i < 16; ++i) st[i] += bconst;
                } else {
#pragma unroll
                    for (int i = 0; i < 16; ++i) { int dist = (32 * qt + r) - (kt * 32 + crow(i, hh)) + 64 * (8 - kc); dist = dist < -63 ? -63 : (dist > 128 ? 128 : dist); st[i] += bias[dist + 63]; }
                }
                float mx = st[0];
#pragma unroll
                for (int i = 1; i < 16; ++i) mx = fmaxf(mx, st[i]);
                mx = fmaxf(mx, __shfl_xor(mx, 32));
                const float mnew = fmaxf(mrun[qt], mx), alpha = __expf(mrun[qt] - mnew);
                float ls = 0.f;
#pragma unroll
                for (int i = 0; i < 16; ++i) { st[i] = __expf(st[i] - mnew); ls += st[i]; }
                ls += __shfl_xor(ls, 32);
                lrun[qt] = lrun[qt] * alpha + ls; mrun[qt] = mnew;
#pragma unroll
                for (int dt = 0; dt < 2; ++dt)
#pragma unroll
                    for (int i = 0; i < 16; ++i) oacc[dt][qt][i] *= alpha;
                bf16x8 pk[2];
#pragma unroll
                for (int s2 = 0; s2 < 2; ++s2) { u32x4 w; w.x = cvtpk(st[8 * s2], st[8 * s2 + 1]); w.y = cvtpk(st[8 * s2 + 2], st[8 * s2 + 3]); w.z = cvtpk(st[8 * s2 + 4], st[8 * s2 + 5]); w.w = cvtpk(st[8 * s2 + 6], st[8 * s2 + 7]); pk[s2] = __builtin_bit_cast(bf16x8, w); }
#pragma unroll
                for (int dt = 0; dt < 2; ++dt)
#pragma unroll
                    for (int s2 = 0; s2 < 2; ++s2) oacc[dt][qt] = MFMA32(vf[dt][s2], pk[s2], oacc[dt][qt]);
            }
        }
    }
#pragma unroll
    for (int qt = 0; qt < 2; ++qt) {
        const float inv = 1.0f / lrun[qt];
        bf16* orow = MIXp + (rowq0 + 32 * qt + r) * D + h * 64;
#pragma unroll
        for (int dt = 0; dt < 2; ++dt)
#pragma unroll
            for (int g4 = 0; g4 < 4; ++g4) { u32x2 w; w.x = cvtpk(oacc[dt][qt][4 * g4] * inv, oacc[dt][qt][4 * g4 + 1] * inv); w.y = cvtpk(oacc[dt][qt][4 * g4 + 2] * inv, oacc[dt][qt][4 * g4 + 3] * inv);
                *(u32x2*)(orow + 32 * dt + 8 * g4 + 4 * hh) = w; }
    }
}

__device__ __forceinline__ f32x2 row16_sum2(f32x2 v) {
    float x = v.x, y = v.y;
#define DPPADD(r, ctl) "v_add_f32_dpp " r ", " r ", " r " " ctl " row_mask:0xf bank_mask:0xf bound_ctrl:1\n\t"
    asm volatile("s_nop 1\n\t"
                 DPPADD("%0", "quad_perm:[1,0,3,2]") DPPADD("%1", "quad_perm:[1,0,3,2]") "s_nop 0\n\t"
                 DPPADD("%0", "quad_perm:[2,3,0,1]") DPPADD("%1", "quad_perm:[2,3,0,1]") "s_nop 0\n\t"
                 DPPADD("%0", "row_ror:4") DPPADD("%1", "row_ror:4") "s_nop 0\n\t"
                 DPPADD("%0", "row_ror:8") DPPADD("%1", "row_ror:8")
                 : "+v"(x), "+v"(y));
#undef DPPADD
    return (f32x2){x, y};
}
constexpr int PREP_TB = 16;
constexpr int XB_STRIDE = 528, XB_BYTES = 16 * XB_STRIDE;
constexpr int WL_OFF = 4 * XB_BYTES;
constexpr int RING_OFF = WL_OFF + 32768;
__device__ __forceinline__ void load_lora_lds(LAS unsigned char* lds, int head, int tid) {
    const float* wup = inp(20); const float* aup = inp(22); const float* gup = inp(23);
    for (int e = tid; e < 64 * 32; e += NTHREADS) {
        const int kc = e >> 6, ch = e & 63, c = head * 64 + ch, k0 = 8 * kc;
        const float* src = (k0 < 64) ? (wup + (size_t)k0 * DH) : (k0 < 128) ? (aup + (size_t)(k0 - 64) * DH) : (gup + (size_t)(k0 - 128) * DH);
        float w[8];
#pragma unroll
        for (int i = 0; i < 8; ++i) w[i] = src[(size_t)i * DH + c];
        u32x4 o; o.x = cvtpk(w[0], w[1]); o.y = cvtpk(w[2], w[3]); o.z = cvtpk(w[4], w[5]); o.w = cvtpk(w[6], w[7]);
        *(LAS u32x4*)(lds + WL_OFF + ch * 512 + ((kc ^ (ch & 15)) * 16)) = o;
    }
}
__device__ __forceinline__ void prep_wave_item(const bf16* Zp, float* SEGp, bf16* GGp, bf16* BVp, LAS unsigned char* XB  , const LAS unsigned char* WLT, int seg, int b, int head, int tb, int lane) {
    const int t0 = seg * SEGT + tb * PREP_TB;
    const float* mu = inp(18);
#pragma unroll 2
    for (int it = 0; it < 8; ++it) {
        const int idx = it * 64 + lane, tk = idx >> 5, col8 = (idx & 31) * 8, t = t0 + tk; const size_t row = (size_t)b * T + t;
        float z[8], zp[8];
        unpack8(*(const u32x4*)(Zp + row * NZ + 3072 + col8), z);
        if (t > 0) unpack8(*(const u32x4*)(Zp + (row - 1) * NZ + 3072 + col8), zp); else {
#pragma unroll
            for (int e = 0; e < 8; ++e) zp[e] = 0.f; }
        const f32x4 m0 = *(const f32x4*)(mu + 3072 + col8), m1 = *(const f32x4*)(mu + 3072 + col8 + 4);
        float x[8];
#pragma unroll
        for (int e = 0; e < 8; ++e) { float v = z[e] + (zp[e] - z[e]) * (e < 4 ? m0[e] : m1[e - 4]);
            if (col8 < 64) v = 1.f - 2.f * __builtin_amdgcn_rcpf(__expf(2.f * v) + 1.f); else if (col8 >= 128) v = fast_sigmoid(v);
            x[e] = v; }
        u32x4 o; o.x = cvtpk(x[0], x[1]); o.y = cvtpk(x[2], x[3]); o.z = cvtpk(x[4], x[5]); o.w = cvtpk(x[6], x[7]);
        *(LAS u32x4*)(XB + tk * XB_STRIDE + col8 * 2) = o;
    }
    const int fr = lane & 15, fq = lane >> 4;
    pg8::f32x4 accw[4], acca[4], accg[4];
#pragma unroll
    for (int n = 0; n < 4; ++n) { accw[n] = (pg8::f32x4){0.f, 0.f, 0.f, 0.f}; acca[n] = accw[n]; accg[n] = accw[n]; }
#define LORA_MFMA(acc_, koff_, nks_) _Pragma("unroll") for (int s = 0; s < (nks_); ++s) { \
        const bf16x8 af = *(const LAS bf16x8*)(XB + fr * XB_STRIDE + ((koff_) + 32 * s + 8 * fq) * 2); \
        _Pragma("unroll") for (int n = 0; n < 4; ++n) { const int chn = 16 * n + fr, chunk = ((koff_) >> 3) + 4 * s + fq; \
            const bf16x8 bfr = *(const LAS bf16x8*)(WLT + chn * 512 + ((chunk ^ fr) * 16)); acc_[n] = __builtin_amdgcn_mfma_f32_16x16x32_bf16(af, bfr, acc_[n], 0, 0, 0); } }
    LORA_MFMA(accw, 0, 2)
    LORA_MFMA(acca, 64, 2)
    LORA_MFMA(accg, 128, 4)
#undef LORA_MFMA
    const int tq = t0 + 4 * fq;
    float kkv[4][4], kpv[4][4], rrv[4][4], vvv[4][4], av[4][4], dec[4][4], rkc[4];
#pragma unroll
    for (int n = 0; n < 4; ++n) {
        const int c = head * 64 + 16 * n + fr;
        const float mur = mu[c], muk = mu[DH + c], muv = mu[2 * DH + c];
        const float w0c = inp(19)[c], a0c = inp(21)[c], kkc = inp(24)[c], kac = inp(25)[c]; rkc[n] = inp(26)[c];
        float zr_p = 0.f, zk_p = 0.f, zv_p = 0.f;
        if (tq > 0) { const size_t rowp = (size_t)b * T + tq - 1; zr_p = bf2f(Zp[rowp * NZ + c]); zk_p = bf2f(Zp[rowp * NZ + DH + c]); zv_p = bf2f(Zp[rowp * NZ + 2 * DH + c]); }
#pragma unroll
        for (int j = 0; j < 4; ++j) {
            const size_t row = (size_t)b * T + tq + j;
            const float zr = bf2f(Zp[row * NZ + c]), zk = bf2f(Zp[row * NZ + DH + c]), zv = bf2f(Zp[row * NZ + 2 * DH + c]);
            const float rr = zr + (zr_p - zr) * mur, kk0 = zk + (zk_p - zk) * muk, vv = zv + (zv_p - zv) * muv;
            zr_p = zr; zk_p = zk; zv_p = zv;
            const float wl = -(w0c + accw[n][j]);
            const float sp = fmaxf(wl, 0.f) + __logf(1.f + __expf(-fabsf(wl)));
            dec[n][j] = __expf(-__expf(-sp - 0.5f));
            const float a = fast_sigmoid(a0c + acca[n][j]);
            av[n][j] = a; kkv[n][j] = kk0 * kkc; kpv[n][j] = kk0 * (1.f + (a - 1.f) * kac); rrv[n][j] = rr; vvv[n][j] = vv;
        }
    }
#pragma unroll
    for (int j = 0; j < 4; ++j) {
        float n2 = 0.f, bo = 0.f;
#pragma unroll
        for (int n = 0; n < 4; ++n) { n2 += kkv[n][j] * kkv[n][j]; bo += rrv[n][j] * kpv[n][j] * rkc[n]; }
        const f32x2 red = row16_sum2((f32x2){n2, bo});
        const float inv = 1.0f / fmaxf(sqrtf(red.x), 1e-12f), bonus = red.y;
        const int t = tq + j; const size_t row = (size_t)b * T + t;
        float* rec = SEGp + ((size_t)((((seg & 1) * NB + b) * 16 + head) * SEGT + (t - seg * SEGT))) * RECF;
#pragma unroll
        for (int n = 0; n < 4; ++n) {
            const int i = 16 * n + fr, c = head * 64 + i; const float kk = kkv[n][j] * inv;
            rec[i] = -kk; rec[64 + i] = dec[n][j]; rec[128 + i] = kk * av[n][j]; rec[192 + i] = kpv[n][j]; rec[256 + i] = rrv[n][j]; rec[320 + i] = vvv[n][j];
            GGp[row * DH + c] = (bf16)(cvtpk(accg[n][j], 0.f) & 0xffff); BVp[row * DH + c] = (bf16)(cvtpk(bonus * vvv[n][j], 0.f) & 0xffff);
        }
    }
}

__device__ __forceinline__ float dot4(const f32x4 a, const f32x4 b) { return (a[0] * b[0] + a[1] * b[1]) + (a[2] * b[2] + a[3] * b[3]); }
__device__ __forceinline__ float row16_sum(float v) {
    v += __builtin_bit_cast(float, __builtin_amdgcn_mov_dpp(__builtin_bit_cast(int, v), 0xB1, 0xF, 0xF, true));
    v += __builtin_bit_cast(float, __builtin_amdgcn_mov_dpp(__builtin_bit_cast(int, v), 0x4E, 0xF, 0xF, true));
    v += __builtin_bit_cast(float, __builtin_amdgcn_mov_dpp(__builtin_bit_cast(int, v), 0x124, 0xF, 0xF, true));
    v += __builtin_bit_cast(float, __builtin_amdgcn_mov_dpp(__builtin_bit_cast(int, v), 0x128, 0xF, 0xF, true));
    return v;
}
template <bool HOT = false> __device__ __forceinline__ void scan_segment(const float* SEGp, float* Yp, LAS unsigned char* lds, int seg, int hidx, int rg, int wv, int lane, f32x4& S) {
    __builtin_amdgcn_s_setprio(3);
    const int kg = lane & 15, rw = lane >> 4;
    const int b = hidx >> 4, h = hidx & 15;
    constexpr int BS = 4, NBATCH = SEGT / BS;
    LAS float* RING = (LAS float*)(lds + RING_OFF) + wv * (2 * BS * 384);
    const float* recs = SEGp + ((size_t)((((seg & 1) * NB + b) * 16 + h) * SEGT)) * RECF;
    const int vrow = rg * 16 + wv * 4;
    float* yout = Yp + ((size_t)b * T + seg * SEGT) * DH + h * 64 + vrow + rw;
    const int k0 = kg * 4;
#pragma unroll
    for (int j = 0; j < BS; ++j) { const float* rp = recs + (size_t)j * RECF;
        *(LAS f32x4*)(RING + j * 384 + 4 * lane) = *(const f32x4*)(rp + 4 * lane);
        *(LAS f32x4*)(RING + j * 384 + 256 + 4 * (lane & 31)) = *(const f32x4*)(rp + 256 + 4 * (lane & 31)); }
#define LOADOPS(dst, dvv, slot_) do { const LAS float* o_ = RING + (slot_) * 384; \
        _Pragma("unroll") for (int q_ = 0; q_ < 5; ++q_) dst[q_] = *(const LAS f32x4*)(o_ + k0 + q_ * 64); dvv = o_[320 + vrow + rw]; } while (0)
    f32x4 cur[5]; float cvv;
    LOADOPS(cur, cvv, 0);
    float sa = row16_sum(dot4(S, cur[0]));
    for (int B = 0; B < NBATCH; ++B) {
        f32x4 pfa[BS], pfb[BS];
        const bool more = (B + 1 < NBATCH);
        if (more) {
#pragma unroll
            for (int j = 0; j < BS; ++j) { const float* rp = recs + (size_t)(BS * (HOT ? (B & 1) : (B + 1)) + j) * RECF;
                pfa[j] = *(const f32x4*)(rp + 4 * lane); pfb[j] = *(const f32x4*)(rp + 256 + 4 * (lane & 31)); }
        }
        float ys[BS];
#pragma unroll
        for (int j = 0; j < BS; ++j) {
            const int slot = (B & 1) * BS + j;
            if (j == BS - 1 && more) {
#pragma unroll
                for (int jj = 0; jj < BS; ++jj) { LAS float* d = RING + (((B + 1) & 1) * BS + jj) * 384;
                    *(LAS f32x4*)(d + 4 * lane) = pfa[jj]; *(LAS f32x4*)(d + 256 + 4 * (lane & 31)) = pfb[jj]; }
            }
            f32x4 nxt[5]; float nvv = 0.f;
            if (j < BS - 1) LOADOPS(nxt, nvv, slot + 1);
            else if (more) LOADOPS(nxt, nvv, ((B + 1) & 1) * BS);
            else {
#pragma unroll
                for (int q = 0; q < 5; ++q) nxt[q] = cur[q]; }
            S = (S * cur[1] + cvv * cur[3]) + sa * cur[2];
            f32x2 pr = {dot4(S, cur[4]), dot4(S, nxt[0])};
            pr = row16_sum2(pr);
            ys[j] = pr.x; sa = pr.y;
#pragma unroll
            for (int q = 0; q < 5; ++q) cur[q] = nxt[q];
            cvv = nvv;
        }
        if (kg == 0) {
#pragma unroll
            for (int j = 0; j < BS; ++j) yout[(size_t)(BS * B + j) * DH] = ys[j]; }
    }
#undef LOADOPS
    __builtin_amdgcn_s_setprio(0);
}

__device__ __forceinline__ float half_sum(float v) {
#pragma unroll
    for (int o = 1; o < 32; o <<= 1) v += __shfl_xor(v, o);
    return v;
}
__device__ __forceinline__ void rwkv_post(const float* Yp, const bf16* GGp, const bf16* BVp, bf16* MIXp, int gw, int NGW, int lane) {
    const float* lw = inp(27); const float* lb = inp(28);
    const int hsel = lane >> 4, cq = lane & 15;
    for (int it = gw; it < M * 4; it += NGW) {
        const int row = it >> 2, c = (4 * (it & 3) + hsel) * 64 + 4 * cq;
        const f32x4 y = *(const f32x4*)(Yp + (size_t)row * DH + c);
        const f32x2 red = row16_sum2((f32x2){(y[0] + y[1]) + (y[2] + y[3]), (y[0] * y[0] + y[1] * y[1]) + (y[2] * y[2] + y[3] * y[3])});
        const float mean = red.x * (1.0f / 64.0f), var = fmaxf(red.y * (1.0f / 64.0f) - mean * mean, 0.f);
        const float rs = __builtin_amdgcn_rsqf(var + 64e-5f);
        const u32x2 bv = *(const u32x2*)(BVp + (size_t)row * DH + c), gg = *(const u32x2*)(GGp + (size_t)row * DH + c);
        const f32x4 w4 = *(const f32x4*)(lw + c), b4 = *(const f32x4*)(lb + c);
        const float o0 = ((y[0] - mean) * rs * w4[0] + b4[0] + bflo(bv.x)) * bflo(gg.x), o1 = ((y[1] - mean) * rs * w4[1] + b4[1] + bfhi(bv.x)) * bfhi(gg.x);
        const float o2 = ((y[2] - mean) * rs * w4[2] + b4[2] + bflo(bv.y)) * bflo(gg.y), o3 = ((y[3] - mean) * rs * w4[3] + b4[3] + bfhi(bv.y)) * bfhi(gg.y);
        u32x2 o; o.x = cvtpk(o0, o1); o.y = cvtpk(o2, o3);
        *(u32x2*)(MIXp + (size_t)row * D + DH + c) = o;
    }
}

__device__ __forceinline__ float gelu_tanh(float x) {
    const float t = 0.7978845608028654f * (x + 0.044715f * x * x * x);
    const float e = __expf(2.f * t);
    const float th = 1.f - 2.f * __builtin_amdgcn_rcpf(e + 1.f);
    return 0.5f * x * (1.f + th);
}
__device__ __forceinline__ void s5_unit(const bf16* U, bf16* YS, LAS unsigned char* lds, int b, int g, int tid) {
    constexpr int CT = 128;
    const int lane = tid & 63, wv = tid >> 6, fr = lane & 15, fq = lane >> 4;
    const int pw = wv & 3, half = wv >> 2, p = 16 * pw + fr, seg = 4 * half + fq;
    LAS bf16* usb0 = (LAS bf16*)lds;
    LAS float* E = (LAS float*)(lds + 2 * CT * 32);
    LAS float* CAR = E + 8 * 64 * 2;
    LAS bf16* Hb0 = (LAS bf16*)(CAR + 128);
    const float* bre_p = inp(34); const float* bim_p = inp(35); const float* cre_p = inp(36); const float* cim_p = inp(37); const float* dsk_p = inp(38);
    const float lr = inp(31)[g * 64 + p], li = inp(32)[g * 64 + p], dt = expf(inp(33)[g]);
    const float mag = expf(lr * dt), are = mag * cosf(li * dt), aim = mag * sinf(li * dt);
    const float den = lr * lr + li * li;
    const float zre = ((are - 1.f) * lr + aim * li) / den, zim = (aim * lr - (are - 1.f) * li) / den;
    bf16x8 bfr_re, bfr_im;
    {
        float wr[8], wi[8];
#pragma unroll
        for (int i = 0; i < 8; ++i) { const int c = 8 * (fq & 1) + i; const float br = bre_p[(g * 64 + p) * 16 + c], bi = bim_p[(g * 64 + p) * 16 + c];
            wr[i] = (fq < 2) ? (zre * br - zim * bi) : 0.f; wi[i] = (fq < 2) ? (zre * bi + zim * br) : 0.f; }
        u32x4 a, c2; a.x = cvtpk(wr[0], wr[1]); a.y = cvtpk(wr[2], wr[3]); a.z = cvtpk(wr[4], wr[5]); a.w = cvtpk(wr[6], wr[7]);
        c2.x = cvtpk(wi[0], wi[1]); c2.y = cvtpk(wi[2], wi[3]); c2.z = cvtpk(wi[4], wi[5]); c2.w = cvtpk(wi[6], wi[7]);
        bfr_re = __builtin_bit_cast(bf16x8, a); bfr_im = __builtin_bit_cast(bf16x8, c2);
    }
    float pwr[16], pwi[16];
    pwr[0] = are; pwi[0] = aim;
#pragma unroll
    for (int q = 1; q < 16; ++q) { pwr[q] = pwr[q - 1] * are - pwi[q - 1] * aim; pwi[q] = pwr[q - 1] * aim + pwi[q - 1] * are; }
    bf16x8 cfrag[4];
#pragma unroll
    for (int s = 0; s < 4; ++s) { const int kk0 = 32 * s + 8 * fq; const float* src = (kk0 < 64) ? (cre_p + g * 1024 + fr * 64 + kk0) : (cim_p + g * 1024 + fr * 64 + (kk0 - 64)); const float sg = (kk0 < 64) ? 1.f : -1.f;
        const f32x4 c0v = *(const f32x4*)src, c1v = *(const f32x4*)(src + 4); u32x4 w; w.x = cvtpk(sg * c0v[0], sg * c0v[1]); w.y = cvtpk(sg * c0v[2], sg * c0v[3]); w.z = cvtpk(sg * c1v[0], sg * c1v[1]); w.w = cvtpk(sg * c1v[2], sg * c1v[3]);
        cfrag[s] = __builtin_bit_cast(bf16x8, w); }
    const float dch = dsk_p[g * 16 + fr];
    if (tid < 64) { CAR[2 * tid] = 0.f; CAR[2 * tid + 1] = 0.f; }
    u32x4 unext = {0u, 0u, 0u, 0u};
    if (tid < 2 * CT) unext = *(const u32x4*)(U + (size_t)(b * T + (tid >> 1)) * DH + g * 16 + (tid & 1) * 8);
    __syncthreads();
    for (int ch = 0; ch < T / CT; ++ch) {
        const int row0 = b * T + ch * CT;
        LAS bf16* usb = usb0 + (ch & 1) * (CT * 16); LAS bf16* Hb = Hb0 + (ch & 1) * (CT * 136);
        if (tid < 2 * CT) {
            const int t = tid >> 1, hf = tid & 1;
            *(LAS u32x4*)(usb + t * 16 + hf * 8) = unext;
            if (ch + 1 < T / CT) unext = *(const u32x4*)(U + (size_t)(row0 + CT + t) * DH + g * 16 + hf * 8);
        }
        __syncthreads();
        float hr[16], hi[16]; float sr = 0.f, si = 0.f;
#pragma unroll
        for (int m = 0; m < 4; ++m) {
            const int tokA = 64 * half + 16 * (fr >> 2) + 4 * m + (fr & 3);
            bf16x8 af = {0, 0, 0, 0, 0, 0, 0, 0};
            if (fq < 2) af = *(const LAS bf16x8*)(usb + tokA * 16 + 8 * fq);
            const pg8::f32x4 z4 = {0.f, 0.f, 0.f, 0.f};
            const pg8::f32x4 ar = __builtin_amdgcn_mfma_f32_16x16x32_bf16(af, bfr_re, z4, 0, 0, 0);
            const pg8::f32x4 ai = __builtin_amdgcn_mfma_f32_16x16x32_bf16(af, bfr_im, z4, 0, 0, 0);
#pragma unroll
            for (int j = 0; j < 4; ++j) { const float nr = are * sr - aim * si + ar[j], ni = are * si + aim * sr + ai[j]; sr = nr; si = ni; hr[4 * m + j] = sr; hi[4 * m + j] = si; }
        }
        E[(seg * 64 + p) * 2] = sr; E[(seg * 64 + p) * 2 + 1] = si;
        __syncthreads();
        float cr = CAR[2 * p], ci = CAR[2 * p + 1];
        for (int s = 0; s < seg; ++s) { const float er = E[(s * 64 + p) * 2], ei = E[(s * 64 + p) * 2 + 1];
            const float nr = pwr[15] * cr - pwi[15] * ci + er, ni = pwr[15] * ci + pwi[15] * cr + ei; cr = nr; ci = ni; }
#pragma unroll
        for (int q = 0; q < 16; ++q) {
            const float fr_ = hr[q] + pwr[q] * cr - pwi[q] * ci, fi_ = hi[q] + pwr[q] * ci + pwi[q] * cr;
            { const unsigned pkd = cvtpk(fr_, fi_); Hb[(seg * 16 + q) * 136 + p] = (bf16)(pkd & 0xffff); Hb[(seg * 16 + q) * 136 + 64 + p] = (bf16)(pkd >> 16); }
            if (q == 15) { hr[15] = fr_; hi[15] = fi_; }
        }
        __syncthreads();
        if (seg == 7) { CAR[2 * p] = hr[15]; CAR[2 * p + 1] = hi[15]; }
        {
            pg8::f32x4 acc = {0.f, 0.f, 0.f, 0.f};
#pragma unroll
            for (int s = 0; s < 4; ++s) { const bf16x8 a = *(const LAS bf16x8*)(Hb + (wv * 16 + fr) * 136 + 32 * s + 8 * fq); acc = __builtin_amdgcn_mfma_f32_16x16x32_bf16(a, cfrag[s], acc, 0, 0, 0); }
#pragma unroll
            for (int j = 0; j < 4; ++j) { const int t = wv * 16 + 4 * fq + j; const float y = acc[j] + dch * bf2f(usb[t * 16 + fr]);
                YS[(size_t)(row0 + t) * DH + g * 16 + fr] = (bf16)(cvtpk(gelu_tanh(y), 0.f) & 0xffff); }
        }
    }
    __syncthreads();
}

__global__ void __launch_bounds__(NTHREADS, 2) fwd_megakernel(Params P) {
    extern __shared__ __attribute__((aligned(16))) unsigned char lds_raw[];
    cg::grid_group grid = cg::this_grid();
    LAS unsigned char* lds = (LAS unsigned char*)lds_raw;
    const int tid = threadIdx.x, lane = tid & 63, wave = __builtin_amdgcn_readfirstlane(tid >> 6);
    const int G = gridDim.x, bid = blockIdx.x;
    const int gw = bid * NWAVES + wave, NGW = G * NWAVES;
    unsigned char* ws = P.ws;
#define OUTP ((float*)(GAS float*)P.out)
#ifndef REP_SYNC
#define REP_SYNC 0
#endif
#ifndef REP_SCAN
#define REP_SCAN 1
#endif
#ifndef REP_PREP
#define REP_PREP 1
#endif
#ifndef REP_P0
#define REP_P0 1
#endif
#ifndef REP_GU
#define REP_GU 1
#endif
#ifndef REP_RWKV
#define REP_RWKV 1
#endif
#ifndef REP_ATT
#define REP_ATT 1
#endif
#ifndef REP_S5
#define REP_S5 1
#endif
#ifndef REP_INPROJ
#define REP_INPROJ 1
#endif
    { volatile LAS unsigned* st0 = (volatile LAS unsigned*)(lds + 131072 + 64); if (threadIdx.x < 2) st0[threadIdx.x] = 0u; __syncthreads(); }
    const XcdBarrier xbar = xcd_barrier_post((unsigned*)(GAS unsigned*)(ws + OFF_BAR), (volatile LAS unsigned*)(lds + 131072 + 64));
#define GSYNC() xcd_barrier(xbar)
#define TICK(k) do { } while (0)
#define HB ((bf16*)wsp(ws, OFF_HB))
#define HB2 ((bf16*)wsp(ws, OFF_SCAN))
#define PB ((bf16*)wsp(ws, OFF_PB))
#define SSP(j) ((float*)wsp(ws, OFF_SS + (size_t)(j) * M * 4))
#define ACT ((bf16*)wsp(ws, OFF_R))
#define MIX ((bf16*)wsp(ws, OFF_MIX))
#define QB ((bf16*)wsp(ws, OFF_QB))
#define KB ((bf16*)wsp(ws, OFF_KB))
#define VT ((bf16*)wsp(ws, OFF_VT))
#define ZB ((bf16*)wsp(ws, OFF_Z))
#define UB ((bf16*)wsp(ws, OFF_U))
#define YS ((bf16*)wsp(ws, OFF_YS))
    for (int rep = 0; rep < REP_P0; ++rep) { if (rep) grid.sync(); const int t_ = opqv((int)threadIdx.x), wv_ = __builtin_amdgcn_readfirstlane(t_ >> 6); p0_prologue(ws, lds, opq((int)blockIdx.x) * NWAVES + wv_, opq((int)gridDim.x) * NWAVES, wv_, t_ & 63); }
    if (P.ws == nullptr) grid.sync();
    GSYNC(); TICK(0);

    for (int rs_ = 0; rs_ < REP_SYNC; ++rs_) GSYNC();
    for (int l = 0; l < 2; ++l) {
        const float* hin0 = (l == 0) ? inp(0) : OUTP;
        for (int rep = 0; rep < ((l == 0) ? REP_GU : 1); ++rep) { if (rep) GSYNC(); EpiSwiGLU E{ACT, SSP(4 * l)}; GEMM_PHASE(EpiSwiGLU, (l == 0) ? HB : HB2, wsp(ws, OFF_WGU1) + l * SZ_WGU, 2 * DFF, D, E); }
        GSYNC(); TICK(1);
        { EpiRes<0> E{hin0, OUTP, HB, SSP(4 * l + 1), 0.5f, nullptr, nullptr}; GEMM_PHASE(EpiRes<0>, ACT, wsp(ws, OFF_WD1) + l * SZ_WD, D, DFF, E); }
        GSYNC(); TICK(2);
        if (l == 0) {
            for (int rep = 0; rep < REP_INPROJ; ++rep) { if (rep) GSYNC(); EpiStore<true> E{SSP(4 * l + 1), nullptr, 0, QB, KB, VT, ZB}; GEMM_PHASE(EpiStore<true>, HB, wsp(ws, OFF_WIN0), NIN0, D, E); }
            GSYNC(); TICK(3);
            #define HMAP const int x_ = bid_ & 7, y_ = bid_ >> 3, rg_ = y_ & 3, hidx_ = (y_ >> 2) * 8 + x_;
            #define OPQ_IDS const int t_ = opqv((int)threadIdx.x), ln_ = t_ & 63, bid_ = opq((int)blockIdx.x), G_ = opq((int)gridDim.x), gw_ = bid_ * NWAVES + __builtin_amdgcn_readfirstlane(t_ >> 6), NGW_ = G_ * NWAVES; (void)ln_; (void)gw_; (void)NGW_;
            { OPQ_IDS qknorm_rows(QB, KB, gw_, NGW_, ln_); }
            GSYNC(); TICK(4);
            for (int rep = 0; rep < REP_ATT; ++rep) { if (rep) GSYNC(); OPQ_IDS const float* biasg = inp(17);
#pragma unroll 1
            for (int k2_ = 0; ; ++k2_) { const int v_ = 2 * gw_ + (k2_ & 1) + (k2_ >> 1) * 2 * NGW_; if (v_ >= NB * 64 * 16) break; const int bh_ = v_ >> 6, c_ = v_ & 63;
                attn_unit(QB, KB, VT, MIX, biasg, (((bh_ >> 4) * 64 + c_) << 4) | (bh_ & 15), ln_); } }
            GSYNC(); TICK(4);
            { OPQ_IDS HMAP load_lora_lds(lds, hidx_ & 15, t_); __syncthreads(); }
            for (int rep = 0; rep < REP_RWKV; ++rep) { f32x4 Sst = {0.f, 0.f, 0.f, 0.f};
              for (int s = 0; s <= NSEG; ++s) {
                if (REP_SCAN > 1 && s >= 1) { OPQ_IDS HMAP f32x4 Sd = Sst; if ((t_ >> 6) < 4) scan_segment<(REP_SCAN > 2)>((const float*)wsp(ws, OFF_SCAN), (float*)wsp(ws, OFF_YRAW), lds, s - 1, hidx_, rg_, __builtin_amdgcn_readfirstlane(t_ >> 6), ln_, Sd); }
                if (s >= 1) { OPQ_IDS HMAP if ((t_ >> 6) < 4) scan_segment((const float*)wsp(ws, OFF_SCAN), (float*)wsp(ws, OFF_YRAW), lds, s - 1, hidx_, rg_, __builtin_amdgcn_readfirstlane(t_ >> 6), ln_, Sst); }
                if (s < NSEG) for (int rp_ = 0; rp_ < REP_PREP; ++rp_) { OPQ_IDS HMAP const int wv_ = __builtin_amdgcn_readfirstlane(t_ >> 6), pw_ = wv_ - 4;
                  if (s == 0) { for (int tb_ = rg_ * 8 + wv_; tb_ < SEGT / PREP_TB; tb_ += 32)
                      prep_wave_item(ZB, (float*)wsp(ws, OFF_SCAN), (bf16*)wsp(ws, OFF_GG), (bf16*)wsp(ws, OFF_BV), (wv_ < 4) ? (lds + RING_OFF + wv_ * XB_BYTES) : (lds + pw_ * XB_BYTES), lds + WL_OFF, s, hidx_ >> 4, hidx_ & 15, tb_, ln_); }
                  else if (pw_ >= 0) for (int tb_ = rg_ * 4 + pw_; tb_ < SEGT / PREP_TB; tb_ += 16) prep_wave_item(ZB, (float*)wsp(ws, OFF_SCAN), (bf16*)wsp(ws, OFF_GG), (bf16*)wsp(ws, OFF_BV), lds + pw_ * XB_BYTES, lds + WL_OFF, s, hidx_ >> 4, hidx_ & 15, tb_, ln_); }
                GSYNC(); TICK(5);
              } }
            { OPQ_IDS rwkv_post((const float*)wsp(ws, OFF_YRAW), (const bf16*)wsp(ws, OFF_GG), (const bf16*)wsp(ws, OFF_BV), MIX, gw_, NGW_, ln_); }
            GSYNC(); TICK(5);
            { EpiRes<0> E{OUTP, OUTP, HB, SSP(4 * l + 2), 1.0f, nullptr, nullptr}; GEMM_PHASE(EpiRes<0>, MIX, wsp(ws, OFF_WOUT0), D, D, E); }
            GSYNC(); TICK(7);
        } else {
            { EpiStore<false> E{SSP(4 * l + 1), UB, DH, nullptr, nullptr, nullptr, nullptr}; GEMM_PHASE(EpiStore<false>, HB, wsp(ws, OFF_WSIN), DH, D, E); }
            GSYNC(); TICK(7);
            for (int rep = 0; rep < REP_S5; ++rep) { if (rep) GSYNC(); OPQ_IDS for (int un = bid_; un < NB * 64; un += G_) s5_unit(UB, YS, lds, un >> 6, un & 63, t_); } GSYNC(); TICK(6);
            { EpiRes<1> E{OUTP, OUTP, HB, SSP(4 * l + 2), 1.0f, nullptr, nullptr}; GEMM_PHASE(EpiRes<1>, YS, wsp(ws, OFF_WSOUT), 2 * D, DH, E); }
            GSYNC(); TICK(7);
        }
        { EpiSwiGLU E{ACT, SSP(4 * l + 2)}; GEMM_PHASE(EpiSwiGLU, HB, wsp(ws, OFF_WGU2) + l * SZ_WGU, 2 * DFF, D, E); }
        GSYNC(); TICK(1);
        { EpiRes<0> E{OUTP, OUTP, HB, SSP(4 * l + 3), 0.5f, nullptr, nullptr}; GEMM_PHASE(EpiRes<0>, ACT, wsp(ws, OFF_WD2) + l * SZ_WD, D, DFF, E); }
        { EpiStore<false> E{nullptr, MIX, D, nullptr, nullptr, nullptr, nullptr}; GEMM_PHASE(EpiStore<false>, PB + (size_t)l * M * DPLE, wsp(ws, OFF_WPP) + l * SZ_WPP, D, DPLE, E); }
        GSYNC(); TICK(2);
        { EpiRes<2> E{OUTP, OUTP, (l == 0) ? HB2 : (bf16*)nullptr  , (l == 0) ? (SSP(4 * l + 4)) : nullptr, 1.0f, SSP(4 * l + 3), MIX}; GEMM_PHASE(EpiRes<2>, HB, wsp(ws, OFF_WPG) + l * SZ_WPG, D, D, E); }
        if (l == 0) GSYNC(); TICK(7);
    }
}

extern "C" void kernel_launch(void* const* d_in, const int* in_sizes, int n_in, void* d_out, int out_size, void* d_ws, size_t ws_size, hipStream_t stream) {
    static int grid_blocks = 0;
    if (grid_blocks == 0) {
        int dev = 0, cus = 0, per_cu = 0;
        hipGetDevice(&dev); hipDeviceGetAttribute(&cus, hipDeviceAttributeMultiprocessorCount, dev);
        hipFuncSetAttribute((const void*)fwd_megakernel, hipFuncAttributeMaxDynamicSharedMemorySize, LDS_BYTES);
        hipOccupancyMaxActiveBlocksPerMultiprocessor(&per_cu, (const void*)fwd_megakernel, NTHREADS, LDS_BYTES);
        if (per_cu < 1) { fprintf(stderr, "occupancy query returned %d\n", per_cu); per_cu = 1; }
        grid_blocks = cus * per_cu;
        if (ws_size < WS_END) fprintf(stderr, "workspace too small: %zu < %zu\n", ws_size, (size_t)WS_END);
    }
    (void)hipMemsetAsync((unsigned char*)d_ws + OFF_BAR, 0, BAR_BYTES, stream);
    Params p{};
    unsigned char* ws = (unsigned char*)d_ws;
    for (int i = 0; i < 40; ++i) p.in[i] = (const float*)d_in[i];
    p.out = (float*)d_out; p.ws = ws;

    void* args[] = {&p};
    hipError_t e = hipLaunchCooperativeKernel((const void*)fwd_megakernel, dim3(grid_blocks), dim3(NTHREADS), args, LDS_BYTES, stream);
    if (e != hipSuccess) fprintf(stderr, "cooperative launch failed: %s (grid %d)\n", hipGetErrorString(e), grid_blocks);
}
```
